# Optimizing an MI355X kernel written in HIP

```python
import math, functools
import jax, jax.numpy as jnp
from jax import lax
import numpy as np

D_MODEL = 1024
BATCH = 4
SEQ = 4096
DEPTH = 1
DEC_BATCH = 32
DEC_SEQ = 64
PAST_LEN = 1024

CHUNK = 64
D_MIX = D_MODEL
ATTN_WIDTH = D_MIX // 2
HEAD_DIM = 64
N_HEADS = ATTN_WIDTH // HEAD_DIM
N_KV_HEADS = 2
Q_PER_KV = N_HEADS // N_KV_HEADS
WINDOW = 128
WIN_CHUNKS = WINDOW // CHUNK
SSM_WIDTH = D_MIX - ATTN_WIDTH
SSM_GROUP = 16
SSM_GROUPS = SSM_WIDTH // SSM_GROUP
SSM_STATE = 64
D_FF = -(-8 * D_MODEL // (3 * 256)) * 256
PROJ_Q = N_HEADS * HEAD_DIM
PROJ_KV = N_KV_HEADS * HEAD_DIM
D_IN_PROJ = PROJ_Q + 2 * PROJ_KV + SSM_WIDTH
DN_ALPHA = (2.0 * DEPTH) ** 0.25
DN_BETA = (8.0 * DEPTH) ** -0.25
LN_EPS = 1e-5
NEG_INF = -1e30

kernel_name = "hymba_swa_sink_s5_deepnorm_stream_step"


def layer_norm(x, g, b):
    xf = x.astype(jnp.float32)
    mu = jnp.mean(xf, -1, keepdims=True)
    var = jnp.mean(jnp.square(xf - mu), -1, keepdims=True)
    return ((xf - mu) * lax.rsqrt(var + LN_EPS) * g.astype(jnp.float32) + b.astype(jnp.float32)).astype(x.dtype)


def sink_attention(q, k, v, sinks, mask):
    s = jnp.einsum('...qkgd,...skd->...kgqs', q, k).astype(jnp.float32) * (HEAD_DIM ** -0.5)
    if mask is not None:
        s = jnp.where(mask, s, NEG_INF)
    sink = sinks.astype(jnp.float32).reshape(N_KV_HEADS, Q_PER_KV, 1, 1)
    m = jnp.maximum(jnp.max(s, -1, keepdims=True), sink)
    p = jnp.exp(s - m)
    w = p / (jnp.sum(p, -1, keepdims=True) + jnp.exp(sink - m))
    return jnp.einsum('...kgqs,...skd->...qkgd', w.astype(v.dtype), v)


def prompt_window_attention(q, k, v, sinks, win_rows):
    B, L = q.shape[:2]
    nc = L // CHUNK
    qb = q.reshape(B, nc, CHUNK, N_KV_HEADS, Q_PER_KV, HEAD_DIM)
    pad = ((0, 0), (WIN_CHUNKS, 0), (0, 0), (0, 0), (0, 0))
    kp = jnp.pad(k.reshape(B, nc, CHUNK, N_KV_HEADS, HEAD_DIM), pad)
    vp = jnp.pad(v.reshape(B, nc, CHUNK, N_KV_HEADS, HEAD_DIM), pad)
    kband = jnp.concatenate([kp[:, j:j + nc] for j in range(WIN_CHUNKS + 1)], axis=2)
    vband = jnp.concatenate([vp[:, j:j + nc] for j in range(WIN_CHUNKS + 1)], axis=2)
    key_chunk = (jnp.arange(nc)[:, None] - WIN_CHUNKS
                 + jnp.repeat(jnp.arange(WIN_CHUNKS + 1), CHUNK)[None, :])
    mask = (key_chunk >= 0)[:, None, None, None, :]
    out = sink_attention(qb, kband, vband, sinks, mask)
    return out.reshape(B, L, PROJ_Q), k[:, -win_rows:], v[:, -win_rows:]


def sample_window_attention(q, k, v, sinks, cache_k, cache_v):
    B, S = q.shape[:2]
    k_all = jnp.concatenate([cache_k.astype(k.dtype), k], axis=1)
    v_all = jnp.concatenate([cache_v.astype(v.dtype), v], axis=1)
    out = sink_attention(q.reshape(B, S, N_KV_HEADS, Q_PER_KV, HEAD_DIM), k_all, v_all, sinks, None)
    win_rows = cache_k.shape[1]
    return out.reshape(B, S, PROJ_Q), k_all[:, -win_rows:], v_all[:, -win_rows:]


def s5_mixer(u, h0_re, h0_im, lam_re, lam_im, log_step, b_re, b_im, c_re, c_im, d_skip, w_glu, b_glu):
    Bn, L = u.shape[:2]
    f32 = jnp.float32
    dt = jnp.exp(log_step.astype(f32))[:, None]
    lr, li = lam_re.astype(f32), lam_im.astype(f32)
    mag = jnp.exp(lr * dt)
    ab_re, ab_im = mag * jnp.cos(li * dt), mag * jnp.sin(li * dt)
    nr, ni = ab_re - 1.0, ab_im
    den = lr * lr + li * li
    f_re, f_im = (nr * lr + ni * li) / den, (ni * lr - nr * li) / den
    br, bi = b_re.astype(f32), b_im.astype(f32)
    bb_re = f_re[..., None] * br - f_im[..., None] * bi
    bb_im = f_re[..., None] * bi + f_im[..., None] * br
    ug = u.astype(f32).reshape(Bn, L, SSM_GROUPS, SSM_GROUP)
    bu_re = jnp.einsum('blgc,gpc->blgp', ug, bb_re)
    bu_im = jnp.einsum('blgc,gpc->blgp', ug, bb_im)
    h0r, h0i = h0_re.astype(f32), h0_im.astype(f32)
    bu_re = bu_re.at[:, 0].add(ab_re * h0r - ab_im * h0i)
    bu_im = bu_im.at[:, 0].add(ab_re * h0i + ab_im * h0r)
    a_re = jnp.broadcast_to(ab_re, bu_re.shape)
    a_im = jnp.broadcast_to(ab_im, bu_im.shape)

    def combine(e1, e2):
        a1r, a1i, b1r, b1i = e1
        a2r, a2i, b2r, b2i = e2
        return (a2r * a1r - a2i * a1i, a2r * a1i + a2i * a1r,
                a2r * b1r - a2i * b1i + b2r, a2r * b1i + a2i * b1r + b2i)

    _, _, hr, hi = lax.associative_scan(combine, (a_re, a_im, bu_re, bu_im), axis=1)
    y = (jnp.einsum('blgp,gcp->blgc', hr, c_re.astype(f32))
         - jnp.einsum('blgp,gcp->blgc', hi, c_im.astype(f32)))
    y = y.reshape(Bn, L, SSM_WIDTH) + d_skip.astype(f32) * u.astype(f32)
    y = jax.nn.gelu(y, approximate=False)
    y = y * jax.nn.sigmoid(y @ w_glu.astype(f32) + b_glu.astype(f32))
    return y.astype(u.dtype), hr[:, -1], hi[:, -1]


def trunk_layer(x, attn, h0_re, h0_im, w_in, lam_re, lam_im, log_step, b_re, b_im, c_re, c_im,
                d_skip, w_glu, b_glu, w_out, ln1_g, ln1_b, w_gate_up, w_down, ln2_g, ln2_b):
    B, L, _ = x.shape
    proj = x @ w_in
    q, k, v, u = jnp.split(proj, [PROJ_Q, PROJ_Q + PROJ_KV, PROJ_Q + 2 * PROJ_KV], axis=-1)
    q = q.reshape(B, L, N_HEADS, HEAD_DIM)
    k = k.reshape(B, L, N_KV_HEADS, HEAD_DIM)
    v = v.reshape(B, L, N_KV_HEADS, HEAD_DIM)
    a, new_k, new_v = attn(q, k, v)
    s, new_re, new_im = s5_mixer(u, h0_re, h0_im, lam_re, lam_im, log_step, b_re, b_im,
                                 c_re, c_im, d_skip, w_glu, b_glu)
    mix = jnp.concatenate([a, s.astype(a.dtype)], axis=-1) @ w_out
    h = layer_norm(DN_ALPHA * x + mix, ln1_g, ln1_b)
    g, up = jnp.split(h @ w_gate_up, 2, axis=-1)
    f = (jax.nn.silu(g) * up) @ w_down
    y = layer_norm(DN_ALPHA * h + f, ln2_g, ln2_b)
    return y, new_k, new_v, new_re, new_im


def setup_inputs(seed: int = 0) -> dict:
    key = jax.random.key(seed)
    ks = jax.random.split(key, 32)
    nrm = lambda k, shape, scale: scale * jax.random.normal(k, shape, jnp.float32)
    win_rows = min(WINDOW, PAST_LEN)
    n_idx = jnp.arange(SSM_STATE, dtype=jnp.float32)
    return {
        'x_prompt': nrm(ks[0], (BATCH, SEQ, D_MODEL), 1.0),
        'x_sample': nrm(ks[1], (DEC_BATCH, DEC_SEQ, D_MODEL), 1.0),
        'cache_win_k': nrm(ks[2], (DEPTH, DEC_BATCH, win_rows, N_KV_HEADS, HEAD_DIM), 1.0),
        'cache_win_v': nrm(ks[3], (DEPTH, DEC_BATCH, win_rows, N_KV_HEADS, HEAD_DIM), 1.0),
        'state_ssm_re': nrm(ks[4], (DEPTH, DEC_BATCH, SSM_GROUPS, SSM_STATE), 0.3),
        'state_ssm_im': nrm(ks[5], (DEPTH, DEC_BATCH, SSM_GROUPS, SSM_STATE), 0.3),
        'ln_in_g': 1.0 + nrm(ks[6], (D_MODEL,), 0.02),
        'ln_in_b': nrm(ks[7], (D_MODEL,), 0.02),
        'w_in': nrm(ks[8], (DEPTH, D_MODEL, D_IN_PROJ), D_MODEL ** -0.5),
        'attn_sinks': nrm(ks[9], (DEPTH, N_HEADS), 0.5),
        'ssm_lambda_re': -0.5 + nrm(ks[10], (DEPTH, SSM_GROUPS, SSM_STATE), 0.01),
        'ssm_lambda_im': math.pi * n_idx + nrm(ks[11], (DEPTH, SSM_GROUPS, SSM_STATE), 0.01),
        'ssm_log_step': jax.random.uniform(ks[12], (DEPTH, SSM_GROUPS), jnp.float32,
                                           math.log(1e-3), math.log(1e-1)),
        'ssm_b_re': nrm(ks[13], (DEPTH, SSM_GROUPS, SSM_STATE, SSM_GROUP), (2 * SSM_GROUP) ** -0.5),
        'ssm_b_im': nrm(ks[14], (DEPTH, SSM_GROUPS, SSM_STATE, SSM_GROUP), (2 * SSM_GROUP) ** -0.5),
        'ssm_c_re': nrm(ks[15], (DEPTH, SSM_GROUPS, SSM_GROUP, SSM_STATE), (2 * SSM_STATE) ** -0.5),
        'ssm_c_im': nrm(ks[16], (DEPTH, SSM_GROUPS, SSM_GROUP, SSM_STATE), (2 * SSM_STATE) ** -0.5),
        'ssm_d': nrm(ks[17], (DEPTH, SSM_WIDTH), 1.0),
        'w_glu': nrm(ks[18], (DEPTH, SSM_WIDTH, SSM_WIDTH), SSM_WIDTH ** -0.5),
        'b_glu': nrm(ks[19], (DEPTH, SSM_WIDTH), 0.02),
        'w_out': nrm(ks[20], (DEPTH, D_MIX, D_MODEL), DN_BETA * D_MIX ** -0.5),
        'ln1_g': 1.0 + nrm(ks[21], (DEPTH, D_MODEL), 0.02),
        'ln1_b': nrm(ks[22], (DEPTH, D_MODEL), 0.02),
        'w_gate_up': nrm(ks[23], (DEPTH, D_MODEL, 2 * D_FF), D_MODEL ** -0.5),
        'w_down': nrm(ks[24], (DEPTH, D_FF, D_MODEL), DN_BETA * D_FF ** -0.5),
        'ln2_g': 1.0 + nrm(ks[25], (DEPTH, D_MODEL), 0.02),
        'ln2_b': nrm(ks[26], (DEPTH, D_MODEL), 0.02),
    }


def reference(x_prompt, x_sample, cache_win_k, cache_win_v, state_ssm_re, state_ssm_im,
              ln_in_g, ln_in_b, w_in, attn_sinks, ssm_lambda_re, ssm_lambda_im, ssm_log_step,
              ssm_b_re, ssm_b_im, ssm_c_re, ssm_c_im, ssm_d, w_glu, b_glu, w_out,
              ln1_g, ln1_b, w_gate_up, w_down, ln2_g, ln2_b):
    win_rows = cache_win_k.shape[2]
    xp = layer_norm(x_prompt, ln_in_g, ln_in_b)
    xs = layer_norm(x_sample, ln_in_g, ln_in_b)
    kp_l, vp_l, rp_l, ip_l, ks_l, vs_l, rs_l, is_l = [], [], [], [], [], [], [], []
    for l in range(DEPTH):
        shared = (w_in[l], ssm_lambda_re[l], ssm_lambda_im[l], ssm_log_step[l], ssm_b_re[l], ssm_b_im[l],
                  ssm_c_re[l], ssm_c_im[l], ssm_d[l], w_glu[l], b_glu[l], w_out[l],
                  ln1_g[l], ln1_b[l], w_gate_up[l], w_down[l], ln2_g[l], ln2_b[l])
        attn_p = functools.partial(prompt_window_attention, sinks=attn_sinks[l], win_rows=win_rows)
        h0 = jnp.zeros((xp.shape[0], SSM_GROUPS, SSM_STATE), jnp.float32)
        xp, k1, v1, r1, i1 = trunk_layer(xp, attn_p, h0, h0, *shared)
        attn_s = functools.partial(sample_window_attention, sinks=attn_sinks[l],
                                   cache_k=cache_win_k[l], cache_v=cache_win_v[l])
        xs, k2, v2, r2, i2 = trunk_layer(xs, attn_s, state_ssm_re[l], state_ssm_im[l], *shared)
        kp_l.append(k1); vp_l.append(v1); rp_l.append(r1); ip_l.append(i1)
        ks_l.append(k2); vs_l.append(v2); rs_l.append(r2); is_l.append(i2)
    return (xp, xs,
            jnp.stack(kp_l), jnp.stack(vp_l), jnp.stack(rp_l), jnp.stack(ip_l),
            jnp.stack(ks_l), jnp.stack(vs_l), jnp.stack(rs_l), jnp.stack(is_l))
```

```cpp
#include <hip/hip_runtime.h>
#include <hip/hip_cooperative_groups.h>
#include <cstdio>
#include <cstdint>
namespace cg = cooperative_groups;
namespace pg8 {
#define PG8_LAS __attribute__((address_space(3)))
typedef unsigned short bf16_t;
typedef short bf16x8 __attribute__((ext_vector_type(8)));
typedef float f32x4 __attribute__((ext_vector_type(4)));
typedef unsigned u32x4 __attribute__((ext_vector_type(4)));
constexpr int BM = 256, BK = 64, HALF = 128, HTB = HALF * BK * 2  , STAGE_BYTES = 8 * HTB, NXCD = 8, WGM = 8;

__host__ __device__ __forceinline__ int lds_byte(int r, int c) { const int st = (r >> 4) * 2 + (c >> 5), rr = r & 15, cc = c & 31, ob = rr * 64 + cc * 2; return st * 1024 + (ob ^ (((ob >> 9) & 1) << 5)); }
__host__ __device__ __forceinline__ void stage_rc(int b, int& R, int& C) { const int st = b / 1024, sb = b % 1024, swz = sb ^ (((sb >> 9) & 1) << 5); R = (st >> 1) * 16 + swz / 64; C = (st & 1) * 32 + (swz % 64) / 2; }
__host__ __device__ __forceinline__ int perm32(int rho) { const int n = rho >> 4, i = rho & 15; return 8 * (i >> 2) + 4 * n + (i & 3); }

__device__ __forceinline__ int lane_id_fresh() { int l; asm volatile("v_mbcnt_lo_u32_b32 %0, -1, 0\n\tv_mbcnt_hi_u32_b32 %0, -1, %0" : "=v"(l)); return l; }
struct Unit { int pm, pn, k0t, nt; };
struct Gemm { const bf16_t* A; const bf16_t* Bt; int M, N, K, ld; };

struct StaticOrder {
    int nM, nN, nwg, G, c;
    __host__ __device__ __forceinline__ void init(int M, int N, int G_, int c_) { nM = M / BM; nN = N / BM; nwg = nM * nN; G = G_; c = c_; }
    __host__ __device__ __forceinline__ bool next(int i, Unit& u) const {
        const long L = (long)i * G + c; if (L >= nwg) return false;
        int wgid = (int)L; { const int q = nwg / NXCD, r = nwg % NXCD, xcd = wgid % NXCD, off = wgid / NXCD; wgid = (xcd < r ? xcd * (q + 1) : r * (q + 1) + (xcd - r) * q) + off; }
        const int nig = WGM * nN, gid = wgid / nig, fm = gid * WGM, gsz = (nM - fm) < WGM ? (nM - fm) : WGM;
        u.pm = fm + ((wgid % nig) % gsz); u.pn = (wgid % nig) / gsz; u.k0t = 0; u.nt = 0; return true;
    }
    __device__ __forceinline__ void a_ready(const Unit&) const {}
    __device__ __forceinline__ void done(const Unit&) const {}
};

__device__ __forceinline__ unsigned cvt_pk_bf16(float lo, float hi) { unsigned r; asm volatile("v_cvt_pk_bf16_f32 %0, %1, %2" : "=v"(r) : "v"(lo), "v"(hi)); return r; }
typedef float f32x2 __attribute__((ext_vector_type(2)));
__device__ __forceinline__ f32x2 gelu_pk(f32x2 v) {
    const f32x2 av = __builtin_elementwise_abs(v), d = av * 0.2316418882f + 1.0f;
    f32x2 t; t.x = __builtin_amdgcn_rcpf(d.x); t.y = __builtin_amdgcn_rcpf(d.y);
    f32x2 q = t * 0.5307027145f + (-0.7265760135f); q = q * t + 0.7107068705f; q = q * t + (-0.142248368f); q = q * t + 0.127414796f; q = q * t;
    const f32x2 s = (v * v) * (-0.72134752044f);
    f32x2 e; e.x = __builtin_amdgcn_exp2f(s.x); e.y = __builtin_amdgcn_exp2f(s.y);
    const f32x2 m = v * (q * e), r = v - m;
    f32x2 o; o.x = v.x < 0.f ? m.x : r.x; o.y = v.y < 0.f ? m.y : r.y; return o;
}

template <int ACT  > struct EpiBf16 {
    static constexpr bool PERM = true, AFTER_DRAIN = false; static_assert(ACT == 0 || ACT == 1, "EpiBf16: ACT is 0 (none) or 1 (gelu_pk)");
    bf16_t* O; int ldc; const float* bias; int split_cols; size_t split_stride; float scale0;
    __device__ __forceinline__ void operator()(const f32x4 (&acc)[2][2][4][2], const Unit& u, int wr, int wc, int fr, int fq) const {
        const int row0 = u.pm * BM + wr * 64 + fr; int colt = u.pn * BM; bf16_t* base = O;
        float sc = 1.f; if (split_cols) { const int t = colt / split_cols; base += (size_t)t * split_stride; colt -= t * split_cols; if (t == 0) sc = scale0; }
        const int col0 = colt + wc * 32 + 8 * fq, bcol0 = u.pn * BM + wc * 32 + 8 * fq;
        f32x4 bv[2][2];
#pragma unroll
        for (int bj = 0; bj < 2; ++bj)
#pragma unroll
            for (int n = 0; n < 2; ++n) bv[bj][n] = bias ? *(const f32x4*)(bias + bcol0 + bj * HALF + 4 * n) : (f32x4){0.f, 0.f, 0.f, 0.f};
#pragma unroll
        for (int ai = 0; ai < 2; ++ai)
#pragma unroll
            for (int m = 0; m < 4; ++m) { bf16_t* rowp = base + (size_t)(row0 + ai * HALF + m * 16) * ldc + col0;
#pragma unroll
                for (int bj = 0; bj < 2; ++bj) { f32x4 v0 = acc[ai][bj][m][0] + bv[bj][0], v1 = acc[ai][bj][m][1] + bv[bj][1];
                    if (ACT == 1) { f32x2 a = gelu_pk((f32x2){v0[0], v0[1]}), b = gelu_pk((f32x2){v0[2], v0[3]}), c = gelu_pk((f32x2){v1[0], v1[1]}), d = gelu_pk((f32x2){v1[2], v1[3]});
                        v0 = (f32x4){a.x, a.y, b.x, b.y}; v1 = (f32x4){c.x, c.y, d.x, d.y}; }
                    v0 = v0 * sc; v1 = v1 * sc; u32x4 w; w.x = cvt_pk_bf16(v0[0], v0[1]); w.y = cvt_pk_bf16(v0[2], v0[3]); w.z = cvt_pk_bf16(v1[0], v1[1]); w.w = cvt_pk_bf16(v1[2], v1[3]);
                    *(u32x4*)(rowp + bj * HALF) = w; } }
    }
};
template <class Epi, class Sched, bool ALIGN_EPI = false, bool SP2 = false>
__device__ __forceinline__ void gemm_phase(PG8_LAS unsigned char* lds, const Gemm g, const Sched& S, const Epi& E, const int wave_id) {
    int tid_ = wave_id * 64 + lane_id_fresh();
    const int tid = tid_, wid = __builtin_amdgcn_readfirstlane(tid >> 6), lane = tid & 63, wr = wid >> 2, wc = wid & 3, fr = lane & 15, fq = lane >> 4;
    const int K = g.ld, nt_full = g.K / BK;
    unsigned voffA[2], voffB[2];
#pragma unroll
    for (int i = 0; i < 2; ++i) { int R, C; stage_rc(tid * 16 + i * 8192, R, C); const int Rb = Epi::PERM ? ((R & ~31) + perm32(R & 31)) : R;
        voffA[i] = (unsigned)(R * K + C) * 2u; voffB[i] = (unsigned)(Rb * K + C) * 2u; }
    const size_t kstep = (size_t)(BK * 2);
    const size_t hstep = (size_t)HALF * K * 2;
    const size_t tstep = 2 * hstep;
    const unsigned ldsw = (unsigned)wid * 1024u;
    const int aoff = lds_byte(wr * 64 + fr, fq * 8), boff = lds_byte(wc * 32 + fr, fq * 8);
#define PG8_SA(b, h) (((b) * 2 + (h)) * HTB)
#define PG8_SB(b, h) ((4 + (b) * 2 + (h)) * HTB)
#define PG8_STAGE(bufoff, gbase, voff) do { _Pragma("unroll") for (int _i = 0; _i < 2; ++_i) \
        __builtin_amdgcn_global_load_lds((const unsigned*)((const char*)(gbase) + (voff)[_i]), (PG8_LAS unsigned*)(lds + (bufoff) + ldsw + _i * 8192), 16, 0, 0); } while (0)
#define PG8_LDA(dst, b, h) do { _Pragma("unroll") for (int m = 0; m < 4; ++m) _Pragma("unroll") for (int k = 0; k < 2; ++k) dst[m][k] = *(const PG8_LAS bf16x8*)(lds + PG8_SA(b, h) + aoff + m * 2048 + k * 1024); } while (0)
#define PG8_LDB(dst, b, h) do { _Pragma("unroll") for (int n = 0; n < 2; ++n) _Pragma("unroll") for (int k = 0; k < 2; ++k) dst[n][k] = *(const PG8_LAS bf16x8*)(lds + PG8_SB(b, h) + boff + n * 2048 + k * 1024); } while (0)
#define PG8_MMA(ai, bj, At, Bt) do { __builtin_amdgcn_s_setprio(1); _Pragma("unroll") for (int m = 0; m < 4; ++m) _Pragma("unroll") for (int n = 0; n < 2; ++n) _Pragma("unroll") for (int k = 0; k < 2; ++k) \
        acc[ai][bj][m][n] = __builtin_amdgcn_mfma_f32_16x16x32_bf16(Bt[n][k], At[m][k], acc[ai][bj][m][n], 0, 0, 0); __builtin_amdgcn_s_setprio(0); } while (0)
#define PG8_WAIT_V(n) asm volatile("s_waitcnt vmcnt(" #n ")" ::: "memory")
#define PG8_WAIT_L(n) asm volatile("s_waitcnt lgkmcnt(" #n ")" ::: "memory")
#define PG8_BAR __builtin_amdgcn_s_barrier()
#define PG8_SCHED __builtin_amdgcn_sched_barrier(0)
    Unit cur, nxt; int ui = 0;
    if (!S.next(0, cur)) return;
    f32x4 acc[2][2][4][2];
#pragma unroll
    for (int a = 0; a < 2; ++a)
#pragma unroll
        for (int b = 0; b < 2; ++b)
#pragma unroll
            for (int m = 0; m < 4; ++m)
#pragma unroll
                for (int n = 0; n < 2; ++n) acc[a][b][m][n] = (f32x4){0.f, 0.f, 0.f, 0.f};
    bf16x8 At[4][2], B0[2][2], B1[2][2];
    const char* cA = (const char*)g.A + (size_t)cur.pm * tstep + (size_t)cur.k0t * kstep; const char* cB = (const char*)g.Bt + (size_t)cur.pn * tstep + (size_t)cur.k0t * kstep;
    int nt = cur.nt ? cur.nt : nt_full;
    S.a_ready(cur);
    if constexpr (SP2) {
        PG8_STAGE(PG8_SB(0, 0), cB, voffB); PG8_STAGE(PG8_SB(0, 1), cB + hstep, voffB); PG8_STAGE(PG8_SA(0, 0), cA, voffA); PG8_STAGE(PG8_SA(0, 1), cA + hstep, voffA);
        if (wr == 1) PG8_BAR;
        PG8_WAIT_V(2); PG8_BAR;
        PG8_STAGE(PG8_SB(1, 0), cB + kstep, voffB); PG8_STAGE(PG8_SA(1, 0), cA + kstep, voffA); PG8_STAGE(PG8_SB(1, 1), cB + hstep + kstep, voffB);
        PG8_WAIT_V(6); PG8_BAR;
    } else {
        PG8_STAGE(PG8_SB(0, 0), cB, voffB); PG8_STAGE(PG8_SA(0, 0), cA, voffA); PG8_STAGE(PG8_SB(0, 1), cB + hstep, voffB); PG8_STAGE(PG8_SA(0, 1), cA + hstep, voffA);
        if (wr == 1) PG8_BAR;
        PG8_WAIT_V(4); PG8_BAR;
        PG8_STAGE(PG8_SB(1, 0), cB + kstep, voffB); PG8_STAGE(PG8_SA(1, 0), cA + kstep, voffA); PG8_STAGE(PG8_SB(1, 1), cB + hstep + kstep, voffB);
        PG8_WAIT_V(6); PG8_BAR;
    }
    for (;;) {
        const bool has_next = S.next(ui + 1, nxt);
        const char* nA = has_next ? (const char*)g.A + (size_t)nxt.pm * tstep + (size_t)nxt.k0t * kstep : cA; const char* nB = has_next ? (const char*)g.Bt + (size_t)nxt.pn * tstep + (size_t)nxt.k0t * kstep : cB;
        for (int t = 0; t < nt; t += 2) {
            const bool last = (t == nt - 2);
            const char* a1 = cA + (size_t)(t + 1) * kstep;
            const char* a2 = last ? nA : cA + (size_t)(t + 2) * kstep; const char* b2 = last ? nB : cB + (size_t)(t + 2) * kstep;
            const char* a3 = a2 + kstep; const char* b3 = b2 + kstep;
            if (last && has_next) S.a_ready(nxt);
            if constexpr (SP2) {
            PG8_LDB(B0, 0, 0); PG8_LDB(B1, 0, 1); PG8_SCHED; PG8_LDA(At, 0, 0); PG8_STAGE(PG8_SA(1, 1), a1 + hstep, voffA);
            PG8_WAIT_V(8); PG8_WAIT_L(0); PG8_BAR; PG8_MMA(0, 0, At, B0); PG8_MMA(0, 1, At, B1); PG8_BAR; PG8_SCHED;
            PG8_LDA(At, 0, 1); PG8_STAGE(PG8_SB(0, 0), b2, voffB); PG8_STAGE(PG8_SB(0, 1), b2 + hstep, voffB); PG8_STAGE(PG8_SA(0, 0), a2, voffA);
            PG8_WAIT_V(8); PG8_WAIT_L(0); PG8_BAR; PG8_MMA(1, 0, At, B0); PG8_MMA(1, 1, At, B1); PG8_BAR; PG8_SCHED;
            PG8_LDB(B0, 1, 0); PG8_LDB(B1, 1, 1); PG8_SCHED; PG8_LDA(At, 1, 0); PG8_STAGE(PG8_SA(0, 1), a2 + hstep, voffA);
            PG8_WAIT_V(8); PG8_WAIT_L(0); PG8_BAR; PG8_MMA(0, 0, At, B0); PG8_MMA(0, 1, At, B1); PG8_BAR; PG8_SCHED;
            PG8_LDA(At, 1, 1); PG8_STAGE(PG8_SB(1, 0), b3, voffB); PG8_STAGE(PG8_SB(1, 1), b3 + hstep, voffB); PG8_STAGE(PG8_SA(1, 0), a3, voffA);
            PG8_WAIT_V(8); PG8_WAIT_L(0); PG8_BAR; PG8_MMA(1, 0, At, B0); PG8_MMA(1, 1, At, B1); PG8_BAR; PG8_SCHED;
            } else {
            PG8_LDB(B0, 0, 0); PG8_SCHED; PG8_LDA(At, 0, 0); PG8_STAGE(PG8_SA(1, 1), a1 + hstep, voffA);
            PG8_WAIT_L(8); PG8_BAR; PG8_WAIT_L(0); PG8_MMA(0, 0, At, B0); PG8_BAR; PG8_SCHED;
            PG8_LDB(B1, 0, 1); PG8_STAGE(PG8_SB(0, 0), b2, voffB);
            PG8_BAR; PG8_WAIT_L(0); PG8_MMA(0, 1, At, B1); PG8_BAR;
            PG8_LDA(At, 0, 1); PG8_STAGE(PG8_SA(0, 0), a2, voffA);
            PG8_BAR; PG8_WAIT_L(0); PG8_MMA(1, 0, At, B0); PG8_BAR; PG8_SCHED;
            PG8_STAGE(PG8_SB(0, 1), b2 + hstep, voffB);
            PG8_WAIT_V(6); PG8_BAR; PG8_MMA(1, 1, At, B1); PG8_BAR;
            PG8_LDB(B0, 1, 0); PG8_SCHED; PG8_LDA(At, 1, 0); PG8_STAGE(PG8_SA(0, 1), a2 + hstep, voffA);
            PG8_WAIT_L(8); PG8_BAR; PG8_WAIT_L(0); PG8_MMA(0, 0, At, B0); PG8_BAR; PG8_SCHED;
            PG8_LDB(B1, 1, 1); PG8_STAGE(PG8_SB(1, 0), b3, voffB);
            PG8_BAR; PG8_WAIT_L(0); PG8_MMA(0, 1, At, B1); PG8_BAR;
            PG8_LDA(At, 1, 1); PG8_STAGE(PG8_SA(1, 0), a3, voffA);
            PG8_BAR; PG8_WAIT_L(0); PG8_MMA(1, 0, At, B0); PG8_BAR; PG8_SCHED;
            PG8_STAGE(PG8_SB(1, 1), b3 + hstep, voffB);
            PG8_WAIT_V(6); PG8_BAR; PG8_MMA(1, 1, At, B1); PG8_BAR;
            }
        }
        if constexpr (ALIGN_EPI) { if (wr == 0) PG8_BAR; }
        if constexpr (!Epi::AFTER_DRAIN) { E(acc, cur, wr, wc, fr, fq); S.done(cur); }
        if (!has_next) break;
#pragma unroll
        for (int a = 0; a < 2; ++a)
#pragma unroll
            for (int b = 0; b < 2; ++b)
#pragma unroll
                for (int m = 0; m < 4; ++m)
#pragma unroll
                    for (int n = 0; n < 2; ++n) acc[a][b][m][n] = (f32x4){0.f, 0.f, 0.f, 0.f};
        cur = nxt; cA = nA; cB = nB; ++ui; nt = cur.nt ? cur.nt : nt_full;
        if constexpr (ALIGN_EPI) { if (wr == 1) PG8_BAR; }
    }
    PG8_WAIT_V(0);
    if constexpr (!ALIGN_EPI) { if (wr == 0) PG8_BAR; }
    PG8_BAR;
    if constexpr (Epi::AFTER_DRAIN) { E.fused(acc, cur, wr, wc, fr, fq, lds, wid, lane); S.done(cur); }
#undef PG8_SA
#undef PG8_SB
#undef PG8_STAGE
#undef PG8_LDA
#undef PG8_LDB
#undef PG8_MMA
#undef PG8_WAIT_V
#undef PG8_WAIT_L
#undef PG8_BAR
#undef PG8_SCHED
}
}

#define GAS __attribute__((address_space(1)))
#define LAS __attribute__((address_space(3)))
typedef unsigned short bf16;
typedef unsigned v4u __attribute__((ext_vector_type(4)));
typedef unsigned v2u __attribute__((ext_vector_type(2)));
typedef float f32x4 __attribute__((ext_vector_type(4)));
typedef float f32x2 __attribute__((ext_vector_type(2)));
typedef float f32x16 __attribute__((ext_vector_type(16)));
typedef short bf16x8 __attribute__((ext_vector_type(8)));
typedef short s16x4 __attribute__((ext_vector_type(4)));
typedef __bf16 bf16x2_t __attribute__((ext_vector_type(2)));
#define MFMA32(a, b, c) __builtin_amdgcn_mfma_f32_32x32x16_bf16((a), (b), (c), 0, 0, 0)

constexpr int NWAVES = 8, NTHR = 512;
constexpr int MP = 16384, MS = 2048, M = MP + MS, D = 1024, NPROJ = 1280, DFF = 2816, SSMW = 512;
constexpr float LN_EPS = 1e-5f, DN_ALPHA = 1.189207115002721f;
constexpr size_t O_Y = 0, O_WKP = 18874368, O_WVP = 18939904, O_SRP = 19005440, O_SIP = 19013632, O_WKS = 19021824, O_WVS = 19546112, O_SRS = 20070400, O_SIS = 20135936;
constexpr size_t MiB = 1u << 20;
constexpr size_t WS_WIN = 1 * MiB, WS_WGLU = 4 * MiB, WS_WOUT = 5 * MiB, WS_WGU = 7 * MiB, WS_WDN = 18 * MiB;
constexpr size_t WS_W1T = 24 * MiB, WS_TZT = 26 * MiB, WS_W3P = 30 * MiB, WS_POW16 = 32 * MiB, WS_POWL = 32 * MiB + 640 * 1024, WS_E = 33 * MiB, WS_BBAR = 33 * MiB + 512 * 1024;
constexpr size_t WS_KBS = 38 * MiB, WS_VTS = 39 * MiB + 512 * 1024;
constexpr size_t WS_PRE = 214 * MiB;
constexpr size_t WS_PART1 = 114 * MiB, WS_PART2 = 78 * MiB;
constexpr size_t WS_QF = 114 * MiB, WS_UF = 132 * MiB, WS_KFP = 150 * MiB, WS_VFP = 154 * MiB;
constexpr size_t WS_H = 42 * MiB, WS_X0 = 78 * MiB, WS_PROJ = 114 * MiB, WS_MIX = 159 * MiB, WS_YS = 195 * MiB, WS_ACT = 114 * MiB, WS_END = 246 * MiB;
static_assert(WS_POW16 + 2048 * 33 * 8 <= WS_POWL && WS_POWL + 2048 * 17 * 8 <= WS_E && WS_E + 4 * 8 * 32 * 128 * 4 <= WS_BBAR && WS_BBAR + 32 * 64 * 16 * 8 <= WS_KBS, "ws map");
static_assert(WS_ACT + (size_t)M * DFF * 2 <= WS_END && WS_YS + (size_t)M * SSMW * 2 <= WS_END && WS_VFP + 4 * MiB <= WS_MIX && WS_MIX + (size_t)M * D * 2 <= WS_YS, "ws map 2");
constexpr int LDS_BYTES = 150528;

__device__ __forceinline__ unsigned pk2(float lo, float hi) { f32x2 v = {lo, hi}; bf16x2_t b = __builtin_convertvector(v, bf16x2_t); return __builtin_bit_cast(unsigned, b); }
__device__ __forceinline__ bf16 f2bf(float f) { return (bf16)(pk2(f, 0.f) & 0xffffu); }
__device__ __forceinline__ float bflo(unsigned w) { return __uint_as_float(w << 16); }
__device__ __forceinline__ float bfhi(unsigned w) { return __uint_as_float(w & 0xffff0000u); }
__device__ __forceinline__ float sigmoidf_(float x) { return __builtin_amdgcn_rcpf(1.0f + __builtin_amdgcn_exp2f(x * -1.44269504089f)); }
__device__ __forceinline__ unsigned swiglu_pk(float g0, float g1, float u0, float u1) {
    const f32x2 g = {g0, g1}, u = {u0, u1}; const f32x2 t = g * -1.44269504089f;
    f32x2 e; e.x = __builtin_amdgcn_exp2f(t.x); e.y = __builtin_amdgcn_exp2f(t.y);
    const f32x2 d = e + 1.0f; f32x2 r; r.x = __builtin_amdgcn_rcpf(d.x); r.y = __builtin_amdgcn_rcpf(d.y);
    const f32x2 o = (g * u) * r; return pk2(o.x, o.y);
}
__device__ __forceinline__ unsigned glu_pk(unsigned yw, float v0, float v1) {
    const f32x2 y = {bflo(yw), bfhi(yw)}, t = (f32x2){v0, v1} * -1.44269504089f;
    f32x2 e; e.x = __builtin_amdgcn_exp2f(t.x); e.y = __builtin_amdgcn_exp2f(t.y);
    const f32x2 d = e + 1.0f; f32x2 r; r.x = __builtin_amdgcn_rcpf(d.x); r.y = __builtin_amdgcn_rcpf(d.y);
    const f32x2 o = y * r; return pk2(o.x, o.y);
}
__device__ __forceinline__ unsigned res_pk(unsigned rw, float a0, float a1) {
    const f32x2 r = {bflo(rw), bfhi(rw)}; const f32x2 o = r * DN_ALPHA + (f32x2){a0, a1}; return pk2(o.x, o.y);
}
__device__ __forceinline__ float wave_sum(float v) {
#pragma unroll
    for (int o = 1; o < 64; o <<= 1) v += __shfl_xor(v, o);
    return v;
}

struct Args { const float* in[27]; float* out; unsigned char* ws; };
enum { I_XP = 0, I_XS, I_CK, I_CV, I_SRE, I_SIM, I_LNG, I_LNB, I_WIN, I_SINK, I_LRE, I_LIM, I_LSTEP, I_BRE, I_BIM, I_CRE, I_CIM, I_DSK, I_WGLU, I_BGLU, I_WOUT, I_L1G, I_L1B, I_WGU, I_WDN, I_L2G, I_L2B };

using pg8::Unit; using pg8::HALF;
__device__ __forceinline__ int vf_off(int key, int d) {
    const int w = key & 31; return (((w >> 4) * 2 + (d >> 5)) * 64 + ((w >> 2) & 1) * 32 + (d & 31)) * 8 + 4 * ((w >> 3) & 1) + (w & 3);
}
struct EpiProj {
    static constexpr bool PERM = true, AFTER_DRAIN = false;
    bf16* QF; bf16* UF; bf16* KFp; bf16* VFp; bf16* KFs; bf16* VFs; float* out;
    __device__ __forceinline__ void operator()(const pg8::f32x4 (&acc)[2][2][4][2], const Unit& u, int wr, int wc, int fr, int fq) const {
        const int row0 = u.pm * 256 + wr * 64 + fr, colb = u.pn * 256 + wc * 32 + 8 * fq;
        if (u.pn != 2) {
#pragma unroll
            for (int ai = 0; ai < 2; ++ai)
#pragma unroll
                for (int m = 0; m < 4; ++m) { const int row = row0 + ai * HALF + m * 16;
#pragma unroll
                    for (int bj = 0; bj < 2; ++bj) { const pg8::f32x4 v0 = acc[ai][bj][m][0], v1 = acc[ai][bj][m][1]; const int col = colb + bj * HALF;
                        v4u w; w.x = pk2(v0[0], v0[1]); w.y = pk2(v0[2], v0[3]); w.z = pk2(v1[0], v1[1]); w.w = pk2(v1[2], v1[3]);
                        if (u.pn < 2) { const int head = col >> 6, d0 = col & 63;
                            *(v4u*)(QF + ((size_t)(((row >> 5) * 8 + head) * 4 + (d0 >> 4)) * 64 + ((d0 >> 3) & 1) * 32 + (row & 31)) * 8) = w; }
                        else { const int c8 = col - 768, g = c8 >> 4;
                            *(v4u*)(UF + ((size_t)(((row >> 9) * 32 + g) * 16 + (row & 15)) * 64 + ((c8 >> 3) & 1) * 32 + ((row & 511) >> 4)) * 8) = w; } } }
        } else {
            const int colk = wc * 32 + 8 * fq, kvh = colk >> 6, d0 = colk & 63;
#pragma unroll
            for (int ai = 0; ai < 2; ++ai)
#pragma unroll
                for (int m = 0; m < 4; ++m) { const int row = row0 + ai * HALF + m * 16;
                    int b, key, nb; bf16 *kf, *vf; float *ok, *ov; bool wout;
                    if (u.pm < 64) { b = row >> 12; key = row & 4095; nb = 128; kf = KFp; vf = VFp; wout = key >= 3968;
                        ok = out + O_WKP + (size_t)(b * 128 + (key - 3968)) * 128 + colk; ov = out + O_WVP + (size_t)(b * 128 + (key - 3968)) * 128 + colk; }
                    else { const int srow = row - MP; b = srow >> 6; const int t = srow & 63; key = 128 + t; nb = 6; kf = KFs; vf = VFs; wout = true;
                        ok = out + O_WKS + (size_t)(b * 128 + 64 + t) * 128 + colk; ov = out + O_WVS + (size_t)(b * 128 + 64 + t) * 128 + colk; }
                    const size_t blk = (size_t)((b * 2 + kvh) * nb + (key >> 5));
                    const pg8::f32x4 k0 = acc[ai][0][m][0], k1 = acc[ai][0][m][1];
                    v4u w; w.x = pk2(k0[0], k0[1]); w.y = pk2(k0[2], k0[3]); w.z = pk2(k1[0], k1[1]); w.w = pk2(k1[2], k1[3]);
                    *(v4u*)(kf + ((blk * 4 + (d0 >> 4)) * 64 + ((d0 >> 3) & 1) * 32 + (key & 31)) * 8) = w;
#pragma unroll
                    for (int n = 0; n < 2; ++n)
#pragma unroll
                        for (int e = 0; e < 4; ++e) vf[blk * 2048 + vf_off(key, d0 + 4 * n + e)] = f2bf(acc[ai][1][m][n][e]);
                    if (wout) {
#pragma unroll
                        for (int n = 0; n < 2; ++n) { *(pg8::f32x4*)(ok + 4 * n) = acc[ai][0][m][n]; *(pg8::f32x4*)(ov + 4 * n) = acc[ai][1][m][n]; } }
                }
        }
    }
};
struct EpiGlu {
    static constexpr bool PERM = true, AFTER_DRAIN = false;
    const bf16* YS; bf16* MIX; const float* bglu;
    __device__ __forceinline__ void operator()(const pg8::f32x4 (&acc)[2][2][4][2], const Unit& u, int wr, int wc, int fr, int fq) const {
        const int row0 = u.pm * 256 + wr * 64 + fr, colb = u.pn * 256 + wc * 32 + 8 * fq;
#pragma unroll
        for (int bj = 0; bj < 2; ++bj) { const int col = colb + bj * HALF;
            const pg8::f32x4 b0 = *(const pg8::f32x4*)(bglu + col), b1 = *(const pg8::f32x4*)(bglu + col + 4);
#pragma unroll
            for (int ai = 0; ai < 2; ++ai)
#pragma unroll
                for (int m = 0; m < 4; ++m) { const int row = row0 + ai * HALF + m * 16;
                    const v4u y = *(const v4u*)(YS + (size_t)row * SSMW + col);
                    const pg8::f32x4 v0 = acc[ai][bj][m][0] + b0, v1 = acc[ai][bj][m][1] + b1;
                    v4u w;
                    w.x = glu_pk(y.x, v0[0], v0[1]); w.y = glu_pk(y.y, v0[2], v0[3]); w.z = glu_pk(y.z, v1[0], v1[1]); w.w = glu_pk(y.w, v1[2], v1[3]);
                    *(v4u*)(MIX + (size_t)row * D + 512 + col) = w; } }
    }
};
struct EpiRes {
    static constexpr bool PERM = false, AFTER_DRAIN = false;
    const bf16* R; float* out;
    __device__ __forceinline__ void operator()(const pg8::f32x4 (&acc)[2][2][4][2], const Unit& u, int wr, int wc, int fr, int fq) const {
        const int row0 = u.pm * 256 + wr * 64 + fr, colb = u.pn * 256 + wc * 32 + 4 * fq;
#pragma unroll
        for (int ai = 0; ai < 2; ++ai)
#pragma unroll
            for (int m = 0; m < 4; ++m) { const size_t off = (size_t)(row0 + ai * HALF + m * 16) * D + colb;
#pragma unroll
                for (int bj = 0; bj < 2; ++bj)
#pragma unroll
                    for (int n = 0; n < 2; ++n) { const v2u r = *(const v2u*)(R + off + bj * HALF + n * 16);
                        pg8::f32x4 o = acc[ai][bj][m][n];
                        o[0] += DN_ALPHA * bflo(r.x); o[1] += DN_ALPHA * bfhi(r.x); o[2] += DN_ALPHA * bflo(r.y); o[3] += DN_ALPHA * bfhi(r.y);
                        *(pg8::f32x4*)(out + off + bj * HALF + n * 16) = o; } }
    }
};
struct EpiSwiglu {
    static constexpr bool PERM = true, AFTER_DRAIN = false;
    bf16* ACT;
    __device__ __forceinline__ void operator()(const pg8::f32x4 (&acc)[2][2][4][2], const Unit& u, int wr, int wc, int fr, int fq) const {
        const int row0 = u.pm * 256 + wr * 64 + fr, col = u.pn * 128 + wc * 32 + 8 * fq;
#pragma unroll
        for (int ai = 0; ai < 2; ++ai)
#pragma unroll
            for (int m = 0; m < 4; ++m) { const int row = row0 + ai * HALF + m * 16;
                const pg8::f32x4 g0 = acc[ai][0][m][0], g1 = acc[ai][0][m][1], u0 = acc[ai][1][m][0], u1 = acc[ai][1][m][1];
                v4u w;
                w.x = swiglu_pk(g0[0], g0[1], u0[0], u0[1]); w.y = swiglu_pk(g0[2], g0[3], u0[2], u0[3]);
                w.z = swiglu_pk(g1[0], g1[1], u1[0], u1[1]); w.w = swiglu_pk(g1[2], g1[3], u1[2], u1[3]);
                *(v4u*)(ACT + (size_t)row * DFF + col) = w; }
    }
};

struct MainTail {
    pg8::StaticOrder S; int nmain, tpm, tpn, k0t, nt; bool has_tail;
    __device__ __forceinline__ void init(int G, int c, int nt_full, int split_nt0, int split_nt1) {
        S.init(MP, D, G, c); nmain = (S.nwg - c + G - 1) / G; if (nmain < 0) nmain = 0;
        has_tail = c < 128 && G >= 128; tpm = 64 + (c >> 4); tpn = (c >> 2) & 3; const int sp = c & 3;
        k0t = sp < 2 ? sp * split_nt0 : 2 * split_nt0 + (sp - 2) * split_nt1; nt = sp < 2 ? split_nt0 : split_nt1; (void)nt_full;
    }
    __device__ __forceinline__ bool next(int i, Unit& u) const { if (i < nmain) return S.next(i, u); if (i == nmain && has_tail) { u.pm = tpm; u.pn = tpn; u.k0t = k0t; u.nt = nt; return true; } return false; }
    __device__ __forceinline__ void a_ready(const Unit&) const {}
    __device__ __forceinline__ void done(const Unit&) const {}
};
struct EpiResTail {
    static constexpr bool PERM = true, AFTER_DRAIN = false;
    const bf16* R; bf16* out; bf16* P;
    __device__ __forceinline__ void operator()(const pg8::f32x4 (&acc)[2][2][4][2], const Unit& u, int wr, int wc, int fr, int fq) const {
        const int colb = u.pn * 256 + wc * 32 + 8 * fq;
        if (u.pm < 64) { const int row0 = u.pm * 256 + wr * 64 + fr;
#pragma unroll
            for (int ai = 0; ai < 2; ++ai)
#pragma unroll
                for (int m = 0; m < 4; ++m) { const size_t off = (size_t)(row0 + ai * HALF + m * 16) * D + colb;
#pragma unroll
                    for (int bj = 0; bj < 2; ++bj) { const v4u r = *(const v4u*)(R + off + bj * HALF);
                        const pg8::f32x4 a0 = acc[ai][bj][m][0], a1 = acc[ai][bj][m][1];
                        v4u w; w.x = res_pk(r.x, a0[0], a0[1]); w.y = res_pk(r.y, a0[2], a0[3]); w.z = res_pk(r.z, a1[0], a1[1]); w.w = res_pk(r.w, a1[2], a1[3]);
                        *(v4u*)(out + off + bj * HALF) = w; } }
        } else { const int row0 = (u.pm - 64) * 256 + wr * 64 + fr;
#pragma unroll
            for (int ai = 0; ai < 2; ++ai)
#pragma unroll
                for (int m = 0; m < 4; ++m) { const size_t off = (size_t)(row0 + ai * HALF + m * 16) * D + colb;
#pragma unroll
                    for (int bj = 0; bj < 2; ++bj) { const pg8::f32x4 a0 = acc[ai][bj][m][0], a1 = acc[ai][bj][m][1];
                        v4u w; w.x = pk2(a0[0], a0[1]); w.y = pk2(a0[2], a0[3]); w.z = pk2(a1[0], a1[1]); w.w = pk2(a1[2], a1[3]);
                        *(v4u*)(P + off + bj * HALF) = w; } }
        }
    }
};

struct Frame {
    LAS unsigned char* lds; int tid, lane, wave, G, gw, NGW, gt, NGT;
    const float* in[27]; float* out; unsigned char* ws;
};

__device__ __forceinline__ void transpose_item(const float* W, int K, int N, bf16* WT, int k0, int sc0, int dr0, LAS float* scr, int lane) {
    float tv[32];
#pragma unroll
    for (int i = 0; i < 32; ++i) tv[i] = W[(size_t)(k0 + 2 * i + (lane >> 5)) * N + sc0 + (lane & 31)];
#pragma unroll
    for (int i = 0; i < 32; ++i) scr[(2 * i + (lane >> 5)) * 33 + (lane & 31)] = tv[i];
    asm volatile("s_waitcnt lgkmcnt(0)" ::: "memory");
    const int c = lane & 7;
#pragma unroll
    for (int j = 0; j < 4; ++j) { const int n = (lane >> 3) + 8 * j; const LAS float* s = scr + (8 * c) * 33 + n;
        v4u o; o.x = pk2(s[0 * 33], s[1 * 33]); o.y = pk2(s[2 * 33], s[3 * 33]); o.z = pk2(s[4 * 33], s[5 * 33]); o.w = pk2(s[6 * 33], s[7 * 33]);
        *(v4u*)(WT + (size_t)(dr0 + n) * K + k0 + 8 * c) = o; }
    asm volatile("s_waitcnt lgkmcnt(0)" ::: "memory");
}
template <bool TO_BF16>
__device__ __forceinline__ void ln_row(const float* xrow, const float* g, const float* b, void* orow, int lane, const bf16* part = nullptr, const bf16* resid = nullptr) {
    const f32x4* xr = (const f32x4*)xrow + lane;
    f32x4 v[4]; float s = 0.f;
    if (part) {
#pragma unroll
        for (int j = 0; j < 4; ++j) { const v2u* pr = (const v2u*)part + lane + 64 * j; const size_t ps = (size_t)MS * D / 4;
            const v2u rr = ((const v2u*)resid)[lane + 64 * j];
            const v2u p0 = pr[0], p1 = pr[ps], p2 = pr[2 * ps], p3 = pr[3 * ps];
            v[j] = (f32x4){(bflo(p0.x) + bflo(p1.x)) + (bflo(p2.x) + bflo(p3.x)), (bfhi(p0.x) + bfhi(p1.x)) + (bfhi(p2.x) + bfhi(p3.x)),
                           (bflo(p0.y) + bflo(p1.y)) + (bflo(p2.y) + bflo(p3.y)), (bfhi(p0.y) + bfhi(p1.y)) + (bfhi(p2.y) + bfhi(p3.y))};
            v[j].x += DN_ALPHA * bflo(rr.x); v[j].y += DN_ALPHA * bfhi(rr.x); v[j].z += DN_ALPHA * bflo(rr.y); v[j].w += DN_ALPHA * bfhi(rr.y);
            s += (v[j].x + v[j].y) + (v[j].z + v[j].w); }
    } else {
#pragma unroll
    for (int j = 0; j < 4; ++j) { v[j] = xr[64 * j]; s += (v[j].x + v[j].y) + (v[j].z + v[j].w); }
    }
    const float mean = wave_sum(s) * (1.f / D); float s2 = 0.f;
#pragma unroll
    for (int j = 0; j < 4; ++j) { v[j] = v[j] - mean; s2 += (v[j].x * v[j].x + v[j].y * v[j].y) + (v[j].z * v[j].z + v[j].w * v[j].w); }
    const float rstd = 1.f / sqrtf(wave_sum(s2) * (1.f / D) + LN_EPS);
#pragma unroll
    for (int j = 0; j < 4; ++j) { const f32x4 gg = ((const f32x4*)g)[lane + 64 * j], bb = ((const f32x4*)b)[lane + 64 * j];
        const f32x4 o = v[j] * rstd * gg + bb;
        if (TO_BF16) { v2u w; w.x = pk2(o.x, o.y); w.y = pk2(o.z, o.w); ((v2u*)orow)[lane + 64 * j] = w; }
        else ((f32x4*)orow)[lane + 64 * j] = o; }
}

template <bool TO_BF16, bool IN_BF16 = false>
__device__ __forceinline__ void ln_rows4(const void* xrow_, size_t xstride, const float* g, const float* b, void* orow, size_t ostride, int lane) {
    f32x4 v[4][4]; float s[4], s2[4];
#pragma unroll
    for (int i = 0; i < 4; ++i)
#pragma unroll
        for (int j = 0; j < 4; ++j) {
            if (IN_BF16) { const v2u w = ((const v2u*)((const bf16*)xrow_ + i * xstride))[lane + 64 * j]; v[i][j] = (f32x4){bflo(w.x), bfhi(w.x), bflo(w.y), bfhi(w.y)}; }
            else v[i][j] = __builtin_nontemporal_load((const f32x4*)((const float*)xrow_ + i * xstride) + lane + 64 * j); }
#pragma unroll
    for (int i = 0; i < 4; ++i) { s[i] = 0.f;
#pragma unroll
        for (int j = 0; j < 4; ++j) s[i] += (v[i][j].x + v[i][j].y) + (v[i][j].z + v[i][j].w); }
#pragma unroll
    for (int o = 1; o < 64; o <<= 1) {
#pragma unroll
        for (int i = 0; i < 4; ++i) s[i] += __shfl_xor(s[i], o); }
#pragma unroll
    for (int i = 0; i < 4; ++i) { const float mean = s[i] * (1.f / D); s2[i] = 0.f;
#pragma unroll
        for (int j = 0; j < 4; ++j) { v[i][j] = v[i][j] - mean; s2[i] += (v[i][j].x * v[i][j].x + v[i][j].y * v[i][j].y) + (v[i][j].z * v[i][j].z + v[i][j].w * v[i][j].w); } }
#pragma unroll
    for (int o = 1; o < 64; o <<= 1) {
#pragma unroll
        for (int i = 0; i < 4; ++i) s2[i] += __shfl_xor(s2[i], o); }
#pragma unroll
    for (int j = 0; j < 4; ++j) { const f32x4 gg = ((const f32x4*)g)[lane + 64 * j], bb = ((const f32x4*)b)[lane + 64 * j];
#pragma unroll
        for (int i = 0; i < 4; ++i) { const float rstd = 1.f / sqrtf(s2[i] * (1.f / D) + LN_EPS); const f32x4 o = v[i][j] * rstd * gg + bb;
            if (TO_BF16) { v2u w; w.x = pk2(o.x, o.y); w.y = pk2(o.z, o.w); ((v2u*)((bf16*)orow + i * ostride))[lane + 64 * j] = w; }
            else __builtin_nontemporal_store(o, (f32x4*)((float*)orow + i * ostride) + lane + 64 * j); } }
}
__device__ __forceinline__ void ssm_polar(const float* const (&in)[27], int g, int p, float k, float& re, float& im) {
    const float dt = expf(in[I_LSTEP][g]); const float lr = in[I_LRE][g * 64 + p], li = in[I_LIM][g * 64 + p];
    const float mag = expf(lr * dt * k);
    double ang = (double)li * (double)dt * (double)k; ang -= 6.283185307179586476925 * rint(ang * 0.15915494309189533577);
    const float a = (float)ang; re = mag * cosf(a); im = mag * sinf(a);
}

__device__ __forceinline__ void p2_ffn_weights(Frame& F, int wi, int nw) {
    LAS float* scr = (LAS float*)(F.lds + F.wave * 16384);
    constexpr int I_GU = 16 * 176, I_DN = 44 * 32;
    for (int it = wi; it < I_GU + I_DN; it += nw) {
        if (it < I_GU) { const int kb = it / 176, nb = it % 176, dr0 = 32 * nb, tile = dr0 >> 8, within = dr0 & 255;
            const int sc0 = within < 128 ? tile * 128 + within : DFF + tile * 128 + within - 128;
            transpose_item(F.in[I_WGU], D, 2 * DFF, (bf16*)(F.ws + WS_WGU), 64 * kb, sc0, dr0, scr, F.lane); }
        else { const int r = it - I_GU, kb = r / 32, nb = r % 32; transpose_item(F.in[I_WDN], DFF, D, (bf16*)(F.ws + WS_WDN), 64 * kb, 32 * nb, 32 * nb, scr, F.lane); }
    }
}
__device__ __forceinline__ void p0a_small(Frame& F) {
    const float* const (&in)[27] = F.in; unsigned char* ws = F.ws;
    for (int idx = F.gt; idx < 32 * 128 * 32; idx += F.NGT) {
        const int c4 = (idx & 31) * 4, r = (idx >> 5) & 127, bb = idx >> 12, kvh = c4 >> 6, d0 = c4 & 63;
        const f32x4 k = *(const f32x4*)(in[I_CK] + (size_t)(bb * 128 + r) * 128 + c4), v = *(const f32x4*)(in[I_CV] + (size_t)(bb * 128 + r) * 128 + c4);
        const size_t blk = (size_t)((bb * 2 + kvh) * 6 + (r >> 5));
        v2u w; w.x = pk2(k.x, k.y); w.y = pk2(k.z, k.w);
        *(v2u*)((bf16*)(ws + WS_KBS) + ((blk * 4 + (d0 >> 4)) * 64 + ((d0 >> 3) & 1) * 32 + (r & 31)) * 8 + (d0 & 7)) = w;
        bf16* vf = (bf16*)(ws + WS_VTS) + blk * 2048;
        vf[vf_off(r, d0)] = f2bf(v.x); vf[vf_off(r, d0 + 1)] = f2bf(v.y); vf[vf_off(r, d0 + 2)] = f2bf(v.z); vf[vf_off(r, d0 + 3)] = f2bf(v.w);
        if (r >= 64) { *(f32x4*)(F.out + O_WKS + (size_t)(bb * 128 + r - 64) * 128 + c4) = k; *(f32x4*)(F.out + O_WVS + (size_t)(bb * 128 + r - 64) * 128 + c4) = v; }
    }
}
__device__ __forceinline__ void p0b_stream(Frame& F) {
    const float* const (&in)[27] = F.in; unsigned char* ws = F.ws;
    LAS float* scr = (LAS float*)(F.lds + F.wave * 16384);
    constexpr int I_IN = 16 * 40, I_GLU = 8 * 16, I_OUT = 16 * 32, NITEMS = I_IN + I_GLU + I_OUT;
    for (int it = F.gw; it < NITEMS; it += F.NGW) {
        int r = it;
        if (r < I_IN) { const int kb = r / 40, nb = r % 40; transpose_item(in[I_WIN], D, NPROJ, (bf16*)(ws + WS_WIN), 64 * kb, 32 * nb, 32 * nb, scr, F.lane); continue; } r -= I_IN;
        if (r < I_OUT) { const int kb = r / 32, nb = r % 32; transpose_item(in[I_WOUT], D, D, (bf16*)(ws + WS_WOUT), 64 * kb, 32 * nb, 32 * nb, scr, F.lane); continue; } r -= I_OUT;
        { const int kb = r / 16, nb = r % 16; transpose_item(in[I_WGLU], SSMW, SSMW, (bf16*)(ws + WS_WGLU), 64 * kb, 32 * nb, 32 * nb, scr, F.lane); }
    }
    for (int m = 4 * F.gw; m < M; m += 4 * F.NGW) {
        const float* xrow = m < MP ? in[I_XP] + (size_t)m * D : in[I_XS] + (size_t)(m - MP) * D;
        ln_rows4<true>(xrow, D, in[I_LNG], in[I_LNB], (bf16*)(ws + WS_X0) + (size_t)m * D, D, F.lane);
    }
}

constexpr int LDS_BB = 131072, LDS_PL = 131072 + 8192;
__device__ __forceinline__ void p1_group_prepare(Frame& F, int g) {
    const float* const (&in)[27] = F.in;
    LAS f32x2* BB = (LAS f32x2*)(F.lds + LDS_BB); LAS f32x2* PL = (LAS f32x2*)(F.lds + LDS_PL);
    for (int e = F.tid; e < 64 * 17; e += NTHR) { float re, im; ssm_polar(in, g, e / 17, (float)(e % 17), re, im); PL[e] = (f32x2){re, im}; }
    for (int e = F.tid; e < 64 * 16; e += NTHR) { const int p = e >> 4, gp = g * 64 + p; float ar, ai; ssm_polar(in, g, p, 1.f, ar, ai);
        const float lr = in[I_LRE][gp], li = in[I_LIM][gp], nr = ar - 1.0f, ni = ai, den = lr * lr + li * li;
        const float fr = (nr * lr + ni * li) / den, fi = (ni * lr - nr * li) / den;
        const float br = in[I_BRE][gp * 16 + (e & 15)], bi = in[I_BIM][gp * 16 + (e & 15)];
        BB[e] = (f32x2){fr * br - fi * bi, fr * bi + fi * br}; }
}
__device__ __forceinline__ void p1_tables(Frame& F, int g, int part) {
    const float* const (&in)[27] = F.in; unsigned char* ws = F.ws;
    const LAS f32x2* BBAR = (const LAS f32x2*)(F.lds + LDS_BB); const LAS f32x2* POWL = (const LAS f32x2*)(F.lds + LDS_PL);
    bf16* TZT = (bf16*)(ws + WS_TZT); bf16* W1T = (bf16*)(ws + WS_W1T); bf16* W3P = (bf16*)(ws + WS_W3P);
    for (int li = part * 264 + F.tid; li < (part + 1) * 264; li += NTHR) { const int p = li / 33, n = li % 33; float re, im;
        ssm_polar(in, g, p, 16.f * (float)n, re, im); ((f32x2*)(ws + WS_POW16))[(g * 33 + n) * 64 + p] = (f32x2){re, im}; }
    for (int li = part * 992 + F.tid; li < (part + 1) * 992; li += NTHR) {
        const int cp = li & 15, c = (li >> 4) & 15, dl = (li >> 8) - 15;
#define TZ_OFF(t, s) ((((size_t)((g * 8 + ((t) >> 1)) * 16 + (s))) * 64 + (cp >> 3) * 32 + 16 * ((t) & 1) + c) * 8 + (cp & 7))
        if (dl < 0) { for (int t = 0; t <= 15 + dl; ++t) TZT[TZ_OFF(t, t - dl)] = 0; continue; }
        float acc = 0.f;
        for (int p = 0; p < 64; ++p) {
            const float cr = in[I_CRE][(g * 16 + c) * 64 + p], ci = in[I_CIM][(g * 16 + c) * 64 + p];
            const f32x2 bb = BBAR[p * 16 + cp], pw = POWL[p * 17 + dl];
            const float zr = bb.x * pw.x - bb.y * pw.y, zi = bb.x * pw.y + bb.y * pw.x;
            acc += cr * zr - ci * zi;
        }
        if (dl == 0 && c == cp) acc += in[I_DSK][g * 16 + c];
        const bf16 v = f2bf(acc);
        for (int s = 0; s <= 15 - dl; ++s) TZT[TZ_OFF(s + dl, s)] = v;
#undef TZ_OFF
    }
    for (int li = part * 128 + F.tid; li < (part + 1) * 128; li += NTHR) {
        const int s = li & 15, p = li >> 4; const f32x2 pw = POWL[p * 17 + 15 - s];
        unsigned wr_[8], wi_[8];
#pragma unroll
        for (int c2 = 0; c2 < 8; ++c2) { const f32x2 b0 = BBAR[p * 16 + 2 * c2], b1 = BBAR[p * 16 + 2 * c2 + 1];
            wr_[c2] = pk2(b0.x * pw.x - b0.y * pw.y, b1.x * pw.x - b1.y * pw.y); wi_[c2] = pk2(b0.x * pw.y + b0.y * pw.x, b1.x * pw.y + b1.y * pw.x); }
        const int pp = 2 * p, rbk = pp >> 5, rr = pp & 31;
        v4u* d0 = (v4u*)(W1T + ((size_t)((g * 4 + rbk) * 16 + s) * 64 + rr) * 8); v4u* d1 = (v4u*)(W1T + ((size_t)((g * 4 + rbk) * 16 + s) * 64 + rr + 1) * 8);
        d0[0] = (v4u){wr_[0], wr_[1], wr_[2], wr_[3]}; d0[32] = (v4u){wr_[4], wr_[5], wr_[6], wr_[7]};
        d1[0] = (v4u){wi_[0], wi_[1], wi_[2], wi_[3]}; d1[32] = (v4u){wi_[4], wi_[5], wi_[6], wi_[7]};
    }
    for (int li = part * 2048 + F.tid; li < (part + 1) * 2048; li += NTHR) {
        const int p = li & 63, row = li >> 6, t = row >> 4, c = row & 15;
        const float cr = in[I_CRE][(g * 16 + c) * 64 + p], ci = in[I_CIM][(g * 16 + c) * 64 + p]; const f32x2 pw = POWL[p * 17 + t + 1];
        const float zr = cr * pw.x - ci * pw.y, zi = cr * pw.y + ci * pw.x;
        const int pp = 2 * p, rb = pp >> 5, w = pp & 31;
        *(unsigned*)(W3P + ((size_t)((((g * 8 + (row >> 5)) * 4 + rb) * 2 + (w >> 4))) * 64 + ((w >> 2) & 1) * 32 + (row & 31)) * 8 + 4 * ((w >> 3) & 1) + (w & 3)) = pk2(zr, -zi);
    }
}

#ifndef REP_P0
#define REP_P0 1
#endif
#ifndef REP_P1
#define REP_P1 1
#endif
#ifndef REP_P2
#define REP_P2 1
#endif
#ifndef REP_P3
#define REP_P3 1
#endif
#ifndef REP_P4
#define REP_P4 1
#endif
#ifndef REP_P5
#define REP_P5 1
#endif
#ifndef REP_P6
#define REP_P6 1
#endif
#ifndef REP_P7
#define REP_P7 1
#endif
#ifndef REP_P8
#define REP_P8 1
#endif
#ifndef REP_P9
#define REP_P9 1
#endif
#ifndef REP_P1T
#define REP_P1T 1
#endif
#ifndef REP_S1
#define REP_S1 1
#endif
#ifndef REP_S3
#define REP_S3 1
#endif
#ifndef REP_FFNW
#define REP_FFNW 1
#endif
#ifndef REP_ATT
#define REP_ATT 1
#endif
#ifndef REP_SSMX
#define REP_SSMX 1
#endif
#ifndef REP_SYNC
#define REP_SYNC 1
#endif
#ifndef REP_SYNCCG
#define REP_SYNCCG 1
#endif
#define GSYNC_CG() do { for (int s_ = 0; s_ < REP_SYNCCG; ++s_) grid.sync(); } while (0)
#define GSYNC() do { for (int s_ = 0; s_ < REP_SYNC; ++s_) xcd_barrier(bar); } while (0)
#define PIN8(a) asm volatile("" : "+v"(a[0]), "+v"(a[1]), "+v"(a[2]), "+v"(a[3]), "+v"(a[4]), "+v"(a[5]), "+v"(a[6]), "+v"(a[7]))
__device__ __forceinline__ void attn_wave(Frame& F, int au) {
    bf16* MIX = (bf16*)(F.ws + WS_MIX);
    const int lane = F.lane, r = lane & 31, h = lane >> 5;
    const int cgl = au >> 1, kvh = au & 1, qh = F.wave >> 2, head = kvh * 4 + (F.wave & 3);
    int row0, kb0; const bf16* kf0; const bf16* vf0;
    if (cgl < 256) { const int b = cgl >> 6, c = cgl & 63; row0 = b * 4096 + c * 64 + qh * 32; kb0 = c >= 2 ? 0 : (c == 1 ? 2 : 4);
        const long blk = (long)(b * 2 + kvh) * 128 + (2 * c - 4);
        kf0 = (const bf16*)(F.ws + WS_KFP) + blk * 2048; vf0 = (const bf16*)(F.ws + WS_VFP) + blk * 2048;
    } else { const int b = cgl - 256; row0 = MP + b * 64 + qh * 32; kb0 = 0;
        const long blk = (long)(b * 2 + kvh) * 6;
        kf0 = (const bf16*)(F.ws + WS_KBS) + blk * 2048; vf0 = (const bf16*)(F.ws + WS_VTS) + blk * 2048; }
    bf16x8 qf[4];
#pragma unroll
    for (int kk = 0; kk < 4; ++kk) qf[kk] = *(const bf16x8*)((const bf16*)(F.ws + WS_QF) + ((size_t)(((row0 >> 5) * 8 + head) * 4 + kk) * 64 + lane) * 8);
    f32x16 s[6];
    { bf16x8 f[2][8];
#pragma unroll
      for (int i = 0; i < 8; ++i) { f[0][i] = (bf16x8){0, 0, 0, 0, 0, 0, 0, 0}; f[1][i] = f[0][i]; }
      if (kb0 == 0) {
#pragma unroll
          for (int i = 0; i < 8; ++i) f[0][i] = *(const bf16x8*)(kf0 + (i * 64 + lane) * 8); }
#pragma unroll
      for (int bt = 0; bt < 3; ++bt) {
          if (bt < 2 && 2 * (bt + 1) >= kb0) {
#pragma unroll
              for (int i = 0; i < 8; ++i) f[(bt + 1) & 1][i] = *(const bf16x8*)(kf0 + (((bt + 1) * 8 + i) * 64 + lane) * 8); }
          if (2 * bt >= kb0) {
              PIN8(f[bt & 1]);
#pragma unroll
              for (int k2 = 0; k2 < 2; ++k2) { f32x16 acc;
#pragma unroll
                  for (int i = 0; i < 16; ++i) acc[i] = 0.f;
#pragma unroll
                  for (int kk = 0; kk < 4; ++kk) acc = MFMA32(f[bt & 1][k2 * 4 + kk], qf[kk], acc);
#pragma unroll
                  for (int i = 0; i < 16; ++i) s[2 * bt + k2][i] = acc[i] * 0.125f; }
          } else {
#pragma unroll
              for (int k2 = 0; k2 < 2; ++k2)
#pragma unroll
                  for (int i = 0; i < 16; ++i) s[2 * bt + k2][i] = -1e30f;
          }
      } }
    const float sink = F.in[I_SINK][head];
    float mx = sink;
#pragma unroll
    for (int kb = 0; kb < 6; ++kb)
#pragma unroll
        for (int i = 0; i < 16; ++i) mx = fmaxf(mx, s[kb][i]);
    mx = fmaxf(mx, __shfl_xor(mx, 32));
    float l = 0.f;
#pragma unroll
    for (int kb = 0; kb < 6; ++kb)
#pragma unroll
        for (int i = 0; i < 16; ++i) { const float p = __expf(s[kb][i] - mx); s[kb][i] = p; l += p; }
    l += __shfl_xor(l, 32); l += __expf(sink - mx);
    f32x16 o[2];
#pragma unroll
    for (int i = 0; i < 16; ++i) { o[0][i] = 0.f; o[1][i] = 0.f; }
    { bf16x8 f[2][8];
#pragma unroll
      for (int i = 0; i < 8; ++i) { f[0][i] = (bf16x8){0, 0, 0, 0, 0, 0, 0, 0}; f[1][i] = f[0][i]; }
      if (kb0 == 0) {
#pragma unroll
          for (int i = 0; i < 8; ++i) f[0][i] = *(const bf16x8*)(vf0 + (i * 64 + lane) * 8); }
#pragma unroll
      for (int bt = 0; bt < 3; ++bt) {
          if (bt < 2 && 2 * (bt + 1) >= kb0) {
#pragma unroll
              for (int i = 0; i < 8; ++i) f[(bt + 1) & 1][i] = *(const bf16x8*)(vf0 + (((bt + 1) * 8 + i) * 64 + lane) * 8); }
          if (2 * bt >= kb0) {
              PIN8(f[bt & 1]);
#pragma unroll
              for (int k2 = 0; k2 < 2; ++k2)
#pragma unroll
                  for (int s2 = 0; s2 < 2; ++s2) { const int kb = 2 * bt + k2;
                      v4u pw; pw.x = pk2(s[kb][8 * s2 + 0], s[kb][8 * s2 + 1]); pw.y = pk2(s[kb][8 * s2 + 2], s[kb][8 * s2 + 3]); pw.z = pk2(s[kb][8 * s2 + 4], s[kb][8 * s2 + 5]); pw.w = pk2(s[kb][8 * s2 + 6], s[kb][8 * s2 + 7]);
                      const bf16x8 pf = __builtin_bit_cast(bf16x8, pw);
#pragma unroll
                      for (int db = 0; db < 2; ++db) o[db] = MFMA32(f[bt & 1][(k2 * 2 + s2) * 2 + db], pf, o[db]); }
          }
      } }
    const float inv = 1.0f / l;
#pragma unroll
    for (int db = 0; db < 2; ++db)
#pragma unroll
        for (int qq = 0; qq < 4; ++qq) { v2u w; w.x = pk2(o[db][4 * qq] * inv, o[db][4 * qq + 1] * inv); w.y = pk2(o[db][4 * qq + 2] * inv, o[db][4 * qq + 3] * inv);
            *(v2u*)(MIX + (size_t)(row0 + r) * D + head * 64 + 32 * db + 8 * qq + 4 * h) = w; }
}

template <int CTRL, int ROWMASK>
__device__ __forceinline__ float dppf(float v) { return __int_as_float(__builtin_amdgcn_update_dpp(0, __float_as_int(v), CTRL, ROWMASK, 0xf, false)); }
constexpr int SSM_T_BYTES = 17408;
constexpr int ATT_SPLIT = 352;
template <int B8>
__device__ __forceinline__ void ssm_rowblock(const bf16* TZT, const bf16* W3P, bf16* YS, const bf16x8 (&uf)[16], const bf16x8 (&hf)[4][2], int g, int lane, int r, int h, int tok0) {
    constexpr int NT = 2 * B8 + 2, N = NT + 8, NBT = (N + 7) / 8;
    f32x16 acc;
#pragma unroll
    for (int i = 0; i < 16; ++i) acc[i] = 0.f;
    const bf16* trow = TZT + ((size_t)(g * 8 + B8) * 16 * 64 + lane) * 8; const bf16* wrow = W3P + ((size_t)(g * 8 + B8) * 8 * 64 + lane) * 8;
    bf16x8 f[2][8];
#pragma unroll
    for (int i = 0; i < 8; ++i) { f[0][i] = (bf16x8){0, 0, 0, 0, 0, 0, 0, 0}; f[1][i] = f[0][i]; }
#pragma unroll
    for (int i = 0; i < 8; ++i) if (i < N) f[0][i] = i < NT ? *(const bf16x8*)(trow + i * 512) : *(const bf16x8*)(wrow + (i - NT) * 512);
#pragma unroll
    for (int bt = 0; bt < NBT; ++bt) {
#pragma unroll
        for (int i = 0; i < 8; ++i) { const int ix = (bt + 1) * 8 + i; if (ix < N) f[(bt + 1) & 1][i] = ix < NT ? *(const bf16x8*)(trow + ix * 512) : *(const bf16x8*)(wrow + (ix - NT) * 512); }
        PIN8(f[bt & 1]);
#pragma unroll
        for (int i = 0; i < 8; ++i) { const int ix = bt * 8 + i; if (ix < N) acc = MFMA32(f[bt & 1][i], ix < NT ? uf[ix < NT ? ix : 0] : hf[ix < NT ? 0 : (ix - NT) >> 1][(ix - NT) & 1], acc); }
    }
#pragma unroll
    for (int qq = 0; qq < 4; ++qq) { const int c0 = 8 * (qq & 1) + 4 * h, t = 2 * B8 + (qq >> 1);
        const pg8::f32x2 g0 = pg8::gelu_pk((pg8::f32x2){acc[4 * qq], acc[4 * qq + 1]}), g1 = pg8::gelu_pk((pg8::f32x2){acc[4 * qq + 2], acc[4 * qq + 3]});
        v2u w; w.x = pk2(g0.x, g0.y); w.y = pk2(g1.x, g1.y);
        *(v2u*)(YS + (size_t)(tok0 + 16 * r + t) * SSMW + 16 * g + c0) = w; }
}
__device__ __forceinline__ void ssm_step3(const bf16* TZT, const bf16* W3P, bf16* YS, const bf16x8 (&uf)[16], const bf16x8 (&hf)[4][2], int g, int lane, int r, int h, int tok0) {
    const bf16* tz = TZT + ((size_t)(g * 8) * 16 * 64 + lane) * 8; const bf16* w3 = W3P + ((size_t)(g * 8) * 8 * 64 + lane) * 8;
    bf16x8 fa[8], fb[8]; f32x16 acc;
#pragma unroll
    for (int i = 0; i < 16; ++i) acc[i] = 0.f;
#define S3_EPI(B8) { _Pragma("unroll") for (int qq = 0; qq < 4; ++qq) { const int c0 = 8 * (qq & 1) + 4 * h, t = 2 * (B8) + (qq >> 1); \
        const pg8::f32x2 g0 = pg8::gelu_pk((pg8::f32x2){acc[4 * qq], acc[4 * qq + 1]}), g1 = pg8::gelu_pk((pg8::f32x2){acc[4 * qq + 2], acc[4 * qq + 3]}); \
        v2u w; w.x = pk2(g0.x, g0.y); w.y = pk2(g1.x, g1.y); *(v2u*)(YS + (size_t)(tok0 + 16 * r + t) * SSMW + 16 * g + c0) = w; } \
        _Pragma("unroll") for (int k = 0; k < 16; ++k) acc[k] = 0.f; }
    fa[0] = *(const bf16x8*)(tz + 0); fa[1] = *(const bf16x8*)(tz + 512); fa[2] = *(const bf16x8*)(w3 + 0); fa[3] = *(const bf16x8*)(w3 + 512); fa[4] = *(const bf16x8*)(w3 + 1024); fa[5] = *(const bf16x8*)(w3 + 1536); fa[6] = *(const bf16x8*)(w3 + 2048); fa[7] = *(const bf16x8*)(w3 + 2560);
    fb[0] = *(const bf16x8*)(w3 + 3072); fb[1] = *(const bf16x8*)(w3 + 3584); fb[2] = *(const bf16x8*)(tz + 8192); fb[3] = *(const bf16x8*)(tz + 8704); fb[4] = *(const bf16x8*)(tz + 9216); fb[5] = *(const bf16x8*)(tz + 9728); fb[6] = *(const bf16x8*)(w3 + 4096); fb[7] = *(const bf16x8*)(w3 + 4608);
    PIN8(fa);
    acc = MFMA32(fa[0], uf[0], acc); acc = MFMA32(fa[1], uf[1], acc); acc = MFMA32(fa[2], hf[0][0], acc); acc = MFMA32(fa[3], hf[0][1], acc); acc = MFMA32(fa[4], hf[1][0], acc); acc = MFMA32(fa[5], hf[1][1], acc); acc = MFMA32(fa[6], hf[2][0], acc); acc = MFMA32(fa[7], hf[2][1], acc);
    fa[0] = *(const bf16x8*)(w3 + 5120); fa[1] = *(const bf16x8*)(w3 + 5632); fa[2] = *(const bf16x8*)(w3 + 6144); fa[3] = *(const bf16x8*)(w3 + 6656); fa[4] = *(const bf16x8*)(w3 + 7168); fa[5] = *(const bf16x8*)(w3 + 7680); fa[6] = *(const bf16x8*)(tz + 16384); fa[7] = *(const bf16x8*)(tz + 16896);
    PIN8(fb);
    acc = MFMA32(fb[0], hf[3][0], acc); acc = MFMA32(fb[1], hf[3][1], acc); S3_EPI(0) acc = MFMA32(fb[2], uf[0], acc); acc = MFMA32(fb[3], uf[1], acc); acc = MFMA32(fb[4], uf[2], acc); acc = MFMA32(fb[5], uf[3], acc); acc = MFMA32(fb[6], hf[0][0], acc); acc = MFMA32(fb[7], hf[0][1], acc);
    fb[0] = *(const bf16x8*)(tz + 17408); fb[1] = *(const bf16x8*)(tz + 17920); fb[2] = *(const bf16x8*)(tz + 18432); fb[3] = *(const bf16x8*)(tz + 18944); fb[4] = *(const bf16x8*)(w3 + 8192); fb[5] = *(const bf16x8*)(w3 + 8704); fb[6] = *(const bf16x8*)(w3 + 9216); fb[7] = *(const bf16x8*)(w3 + 9728);
    PIN8(fa);
    acc = MFMA32(fa[0], hf[1][0], acc); acc = MFMA32(fa[1], hf[1][1], acc); acc = MFMA32(fa[2], hf[2][0], acc); acc = MFMA32(fa[3], hf[2][1], acc); acc = MFMA32(fa[4], hf[3][0], acc); acc = MFMA32(fa[5], hf[3][1], acc); S3_EPI(1) acc = MFMA32(fa[6], uf[0], acc); acc = MFMA32(fa[7], uf[1], acc);
    fa[0] = *(const bf16x8*)(w3 + 10240); fa[1] = *(const bf16x8*)(w3 + 10752); fa[2] = *(const bf16x8*)(w3 + 11264); fa[3] = *(const bf16x8*)(w3 + 11776); fa[4] = *(const bf16x8*)(tz + 24576); fa[5] = *(const bf16x8*)(tz + 25088); fa[6] = *(const bf16x8*)(tz + 25600); fa[7] = *(const bf16x8*)(tz + 26112);
    PIN8(fb);
    acc = MFMA32(fb[0], uf[2], acc); acc = MFMA32(fb[1], uf[3], acc); acc = MFMA32(fb[2], uf[4], acc); acc = MFMA32(fb[3], uf[5], acc); acc = MFMA32(fb[4], hf[0][0], acc); acc = MFMA32(fb[5], hf[0][1], acc); acc = MFMA32(fb[6], hf[1][0], acc); acc = MFMA32(fb[7], hf[1][1], acc);
    fb[0] = *(const bf16x8*)(tz + 26624); fb[1] = *(const bf16x8*)(tz + 27136); fb[2] = *(const bf16x8*)(tz + 27648); fb[3] = *(const bf16x8*)(tz + 28160); fb[4] = *(const bf16x8*)(w3 + 12288); fb[5] = *(const bf16x8*)(w3 + 12800); fb[6] = *(const bf16x8*)(w3 + 13312); fb[7] = *(const bf16x8*)(w3 + 13824);
    PIN8(fa);
    acc = MFMA32(fa[0], hf[2][0], acc); acc = MFMA32(fa[1], hf[2][1], acc); acc = MFMA32(fa[2], hf[3][0], acc); acc = MFMA32(fa[3], hf[3][1], acc); S3_EPI(2) acc = MFMA32(fa[4], uf[0], acc); acc = MFMA32(fa[5], uf[1], acc); acc = MFMA32(fa[6], uf[2], acc); acc = MFMA32(fa[7], uf[3], acc);
    fa[0] = *(const bf16x8*)(w3 + 14336); fa[1] = *(const bf16x8*)(w3 + 14848); fa[2] = *(const bf16x8*)(w3 + 15360); fa[3] = *(const bf16x8*)(w3 + 15872); fa[4] = *(const bf16x8*)(tz + 32768); fa[5] = *(const bf16x8*)(tz + 33280); fa[6] = *(const bf16x8*)(tz + 33792); fa[7] = *(const bf16x8*)(tz + 34304);
    PIN8(fb);
    acc = MFMA32(fb[0], uf[4], acc); acc = MFMA32(fb[1], uf[5], acc); acc = MFMA32(fb[2], uf[6], acc); acc = MFMA32(fb[3], uf[7], acc); acc = MFMA32(fb[4], hf[0][0], acc); acc = MFMA32(fb[5], hf[0][1], acc); acc = MFMA32(fb[6], hf[1][0], acc); acc = MFMA32(fb[7], hf[1][1], acc);
    fb[0] = *(const bf16x8*)(tz + 34816); fb[1] = *(const bf16x8*)(tz + 35328); fb[2] = *(const bf16x8*)(tz + 35840); fb[3] = *(const bf16x8*)(tz + 36352); fb[4] = *(const bf16x8*)(tz + 36864); fb[5] = *(const bf16x8*)(tz + 37376); fb[6] = *(const bf16x8*)(w3 + 16384); fb[7] = *(const bf16x8*)(w3 + 16896);
    PIN8(fa);
    acc = MFMA32(fa[0], hf[2][0], acc); acc = MFMA32(fa[1], hf[2][1], acc); acc = MFMA32(fa[2], hf[3][0], acc); acc = MFMA32(fa[3], hf[3][1], acc); S3_EPI(3) acc = MFMA32(fa[4], uf[0], acc); acc = MFMA32(fa[5], uf[1], acc); acc = MFMA32(fa[6], uf[2], acc); acc = MFMA32(fa[7], uf[3], acc);
    fa[0] = *(const bf16x8*)(w3 + 17408); fa[1] = *(const bf16x8*)(w3 + 17920); fa[2] = *(const bf16x8*)(w3 + 18432); fa[3] = *(const bf16x8*)(w3 + 18944); fa[4] = *(const bf16x8*)(w3 + 19456); fa[5] = *(const bf16x8*)(w3 + 19968); fa[6] = *(const bf16x8*)(tz + 40960); fa[7] = *(const bf16x8*)(tz + 41472);
    PIN8(fb);
    acc = MFMA32(fb[0], uf[4], acc); acc = MFMA32(fb[1], uf[5], acc); acc = MFMA32(fb[2], uf[6], acc); acc = MFMA32(fb[3], uf[7], acc); acc = MFMA32(fb[4], uf[8], acc); acc = MFMA32(fb[5], uf[9], acc); acc = MFMA32(fb[6], hf[0][0], acc); acc = MFMA32(fb[7], hf[0][1], acc);
    fb[0] = *(const bf16x8*)(tz + 41984); fb[1] = *(const bf16x8*)(tz + 42496); fb[2] = *(const bf16x8*)(tz + 43008); fb[3] = *(const bf16x8*)(tz + 43520); fb[4] = *(const bf16x8*)(tz + 44032); fb[5] = *(const bf16x8*)(tz + 44544); fb[6] = *(const bf16x8*)(tz + 45056); fb[7] = *(const bf16x8*)(tz + 45568);
    PIN8(fa);
    acc = MFMA32(fa[0], hf[1][0], acc); acc = MFMA32(fa[1], hf[1][1], acc); acc = MFMA32(fa[2], hf[2][0], acc); acc = MFMA32(fa[3], hf[2][1], acc); acc = MFMA32(fa[4], hf[3][0], acc); acc = MFMA32(fa[5], hf[3][1], acc); S3_EPI(4) acc = MFMA32(fa[6], uf[0], acc); acc = MFMA32(fa[7], uf[1], acc);
    fa[0] = *(const bf16x8*)(tz + 46080); fa[1] = *(const bf16x8*)(tz + 46592); fa[2] = *(const bf16x8*)(w3 + 20480); fa[3] = *(const bf16x8*)(w3 + 20992); fa[4] = *(const bf16x8*)(w3 + 21504); fa[5] = *(const bf16x8*)(w3 + 22016); fa[6] = *(const bf16x8*)(w3 + 22528); fa[7] = *(const bf16x8*)(w3 + 23040);
    PIN8(fb);
    acc = MFMA32(fb[0], uf[2], acc); acc = MFMA32(fb[1], uf[3], acc); acc = MFMA32(fb[2], uf[4], acc); acc = MFMA32(fb[3], uf[5], acc); acc = MFMA32(fb[4], uf[6], acc); acc = MFMA32(fb[5], uf[7], acc); acc = MFMA32(fb[6], uf[8], acc); acc = MFMA32(fb[7], uf[9], acc);
    fb[0] = *(const bf16x8*)(w3 + 23552); fb[1] = *(const bf16x8*)(w3 + 24064); fb[2] = *(const bf16x8*)(tz + 49152); fb[3] = *(const bf16x8*)(tz + 49664); fb[4] = *(const bf16x8*)(tz + 50176); fb[5] = *(const bf16x8*)(tz + 50688); fb[6] = *(const bf16x8*)(tz + 51200); fb[7] = *(const bf16x8*)(tz + 51712);
    PIN8(fa);
    acc = MFMA32(fa[0], uf[10], acc); acc = MFMA32(fa[1], uf[11], acc); acc = MFMA32(fa[2], hf[0][0], acc); acc = MFMA32(fa[3], hf[0][1], acc); acc = MFMA32(fa[4], hf[1][0], acc); acc = MFMA32(fa[5], hf[1][1], acc); acc = MFMA32(fa[6], hf[2][0], acc); acc = MFMA32(fa[7], hf[2][1], acc);
    fa[0] = *(const bf16x8*)(tz + 52224); fa[1] = *(const bf16x8*)(tz + 52736); fa[2] = *(const bf16x8*)(tz + 53248); fa[3] = *(const bf16x8*)(tz + 53760); fa[4] = *(const bf16x8*)(tz + 54272); fa[5] = *(const bf16x8*)(tz + 54784); fa[6] = *(const bf16x8*)(tz + 55296); fa[7] = *(const bf16x8*)(tz + 55808);
    PIN8(fb);
    acc = MFMA32(fb[0], hf[3][0], acc); acc = MFMA32(fb[1], hf[3][1], acc); S3_EPI(5) acc = MFMA32(fb[2], uf[0], acc); acc = MFMA32(fb[3], uf[1], acc); acc = MFMA32(fb[4], uf[2], acc); acc = MFMA32(fb[5], uf[3], acc); acc = MFMA32(fb[6], uf[4], acc); acc = MFMA32(fb[7], uf[5], acc);
    fb[0] = *(const bf16x8*)(w3 + 24576); fb[1] = *(const bf16x8*)(w3 + 25088); fb[2] = *(const bf16x8*)(w3 + 25600); fb[3] = *(const bf16x8*)(w3 + 26112); fb[4] = *(const bf16x8*)(w3 + 26624); fb[5] = *(const bf16x8*)(w3 + 27136); fb[6] = *(const bf16x8*)(w3 + 27648); fb[7] = *(const bf16x8*)(w3 + 28160);
    PIN8(fa);
    acc = MFMA32(fa[0], uf[6], acc); acc = MFMA32(fa[1], uf[7], acc); acc = MFMA32(fa[2], uf[8], acc); acc = MFMA32(fa[3], uf[9], acc); acc = MFMA32(fa[4], uf[10], acc); acc = MFMA32(fa[5], uf[11], acc); acc = MFMA32(fa[6], uf[12], acc); acc = MFMA32(fa[7], uf[13], acc);
    fa[0] = *(const bf16x8*)(tz + 57344); fa[1] = *(const bf16x8*)(tz + 57856); fa[2] = *(const bf16x8*)(tz + 58368); fa[3] = *(const bf16x8*)(tz + 58880); fa[4] = *(const bf16x8*)(tz + 59392); fa[5] = *(const bf16x8*)(tz + 59904); fa[6] = *(const bf16x8*)(tz + 60416); fa[7] = *(const bf16x8*)(tz + 60928);
    PIN8(fb);
    acc = MFMA32(fb[0], hf[0][0], acc); acc = MFMA32(fb[1], hf[0][1], acc); acc = MFMA32(fb[2], hf[1][0], acc); acc = MFMA32(fb[3], hf[1][1], acc); acc = MFMA32(fb[4], hf[2][0], acc); acc = MFMA32(fb[5], hf[2][1], acc); acc = MFMA32(fb[6], hf[3][0], acc); acc = MFMA32(fb[7], hf[3][1], acc); S3_EPI(6)
    fb[0] = *(const bf16x8*)(tz + 61440); fb[1] = *(const bf16x8*)(tz + 61952); fb[2] = *(const bf16x8*)(tz + 62464); fb[3] = *(const bf16x8*)(tz + 62976); fb[4] = *(const bf16x8*)(tz + 63488); fb[5] = *(const bf16x8*)(tz + 64000); fb[6] = *(const bf16x8*)(tz + 64512); fb[7] = *(const bf16x8*)(tz + 65024);
    PIN8(fa);
    acc = MFMA32(fa[0], uf[0], acc); acc = MFMA32(fa[1], uf[1], acc); acc = MFMA32(fa[2], uf[2], acc); acc = MFMA32(fa[3], uf[3], acc); acc = MFMA32(fa[4], uf[4], acc); acc = MFMA32(fa[5], uf[5], acc); acc = MFMA32(fa[6], uf[6], acc); acc = MFMA32(fa[7], uf[7], acc);
    fa[0] = *(const bf16x8*)(w3 + 28672); fa[1] = *(const bf16x8*)(w3 + 29184); fa[2] = *(const bf16x8*)(w3 + 29696); fa[3] = *(const bf16x8*)(w3 + 30208); fa[4] = *(const bf16x8*)(w3 + 30720); fa[5] = *(const bf16x8*)(w3 + 31232); fa[6] = *(const bf16x8*)(w3 + 31744); fa[7] = *(const bf16x8*)(w3 + 32256);
    PIN8(fb);
    acc = MFMA32(fb[0], uf[8], acc); acc = MFMA32(fb[1], uf[9], acc); acc = MFMA32(fb[2], uf[10], acc); acc = MFMA32(fb[3], uf[11], acc); acc = MFMA32(fb[4], uf[12], acc); acc = MFMA32(fb[5], uf[13], acc); acc = MFMA32(fb[6], uf[14], acc); acc = MFMA32(fb[7], uf[15], acc);
    PIN8(fa);
    acc = MFMA32(fa[0], hf[0][0], acc); acc = MFMA32(fa[1], hf[0][1], acc); acc = MFMA32(fa[2], hf[1][0], acc); acc = MFMA32(fa[3], hf[1][1], acc); acc = MFMA32(fa[4], hf[2][0], acc); acc = MFMA32(fa[5], hf[2][1], acc); acc = MFMA32(fa[6], hf[3][0], acc); acc = MFMA32(fa[7], hf[3][1], acc); S3_EPI(7)
#undef S3_EPI
}
__device__ __forceinline__ void ssm_wg(Frame& F, int wgu) {
    const bf16* UF = (const bf16*)(F.ws + WS_UF); const bf16* W1T = (const bf16*)(F.ws + WS_W1T); const bf16* TZT = (const bf16*)(F.ws + WS_TZT); const bf16* W3P = (const bf16*)(F.ws + WS_W3P);
    const f32x2* POW16 = (const f32x2*)(F.ws + WS_POW16); bf16* YS = (bf16*)(F.ws + WS_YS);
    LAS f32x2* T = (LAS f32x2*)(F.lds + F.wave * SSM_T_BYTES);
    LAS f32x2* EX = (LAS f32x2*)(F.lds + 8 * SSM_T_BYTES);
    const int lane = F.lane, r = lane & 31, h = lane >> 5;
    const bool prompt = wgu < 128;
    int g, tok0, b = 0, q = 0; const int j = F.wave;
    if (prompt) { b = wgu >> 5; g = wgu & 31; tok0 = b * 4096 + j * 512; }
    else { const int s_ = (wgu - 128) * 8 + F.wave; g = s_ & 31; q = s_ >> 5; tok0 = MP + q * 512; }
    const int sp = prompt ? r : (r & 3);
    if (j < 7) EX[j * 64 + lane] = (f32x2){0.f, 0.f};
#pragma unroll 11
    for (int n = 0; n < 33; ++n) T[n * 65 + lane] = POW16[(size_t)(g * 33 + n) * 64 + lane];
    bf16x8 uf[16];
#pragma unroll
    for (int ks = 0; ks < 16; ++ks) uf[ks] = *(const bf16x8*)(UF + ((size_t)(((tok0 >> 9) * 32 + g) * 16 + ks) * 64 + lane) * 8);
    f32x16 x[4];
    for (int r1_ = 0; r1_ < REP_S1; ++r1_)
    { const bf16* w1 = W1T + ((size_t)(g * 4) * 16 * 64 + lane) * 8;
      bf16x8 f[2][8];
#pragma unroll
      for (int i = 0; i < 8; ++i) f[0][i] = *(const bf16x8*)(w1 + i * 512);
#pragma unroll
      for (int bt = 0; bt < 8; ++bt) { const int rb = bt >> 1;
          if ((bt & 1) == 0) {
#pragma unroll
              for (int i = 0; i < 16; ++i) x[rb][i] = 0.f; }
          if (bt < 7) {
#pragma unroll
              for (int i = 0; i < 8; ++i) f[(bt + 1) & 1][i] = *(const bf16x8*)(w1 + ((bt + 1) * 8 + i) * 512); }
          PIN8(f[bt & 1]);
#pragma unroll
          for (int i = 0; i < 8; ++i) x[rb] = MFMA32(f[bt & 1][i], uf[(bt & 1) * 8 + i], x[rb]); } }
    const int bb = 8 * q + (r >> 2);
    float dep[4] = {0.f, 0.f, 0.f, 0.f};
#pragma unroll
    for (int rb = 0; rb < 4; ++rb)
#pragma unroll
        for (int qp = 0; qp < 8; ++qp) {
            int hl = h; asm volatile("" : "+v"(hl), "+v"(dep[(rb * 8 + qp) & 3]));
            const int p = 16 * rb + (qp & 1) + 4 * (qp >> 1) + 2 * hl;
            const float xr = x[rb][2 * qp], xi = x[rb][2 * qp + 1];
            float zr = dppf<0x138, 0xf>(xr), zi = dppf<0x138, 0xf>(xi);
            if (sp == 0) { zr = 0.f; zi = 0.f; if (!prompt) { zr = F.in[I_SRE][(bb * 32 + g) * 64 + p]; zi = F.in[I_SIM][(bb * 32 + g) * 64 + p]; } }
#define SSM_LEVEL(d) { const f32x2 ad = T[(d) * 65 + p]; float pr = dppf<0x110 + (d), 0xf>(zr), pi = dppf<0x110 + (d), 0xf>(zi);     \
                if (!prompt && sp < (d)) { pr = 0.f; pi = 0.f; } zr += ad.x * pr - ad.y * pi; zi += ad.x * pi + ad.y * pr; }
            SSM_LEVEL(1) SSM_LEVEL(2)
            if (prompt) { SSM_LEVEL(4) SSM_LEVEL(8)
                const f32x2 am = T[((r & 15) + 1) * 65 + p]; const float br = dppf<0x142, 0xa>(zr), bi = dppf<0x142, 0xa>(zi);
                zr += am.x * br - am.y * bi; zi += am.x * bi + am.y * br; }
#undef SSM_LEVEL
            const f32x2 a1 = T[65 + p];
            const float er = a1.x * zr - a1.y * zi + xr, ei = a1.x * zi + a1.y * zr + xi;
            if (prompt) { if (r == 31) EX[(7 + j) * 64 + p] = (f32x2){er, ei}; }
            else if (sp == 3) { F.out[O_SRS + (size_t)(bb * 32 + g) * 64 + p] = er; F.out[O_SIS + (size_t)(bb * 32 + g) * 64 + p] = ei; }
            x[rb][2 * qp] = zr; x[rb][2 * qp + 1] = zi; dep[(rb * 8 + qp) & 3] = zr;
        }
    __syncthreads();
    if (prompt) {
#pragma unroll
        for (int rb = 0; rb < 4; ++rb)
#pragma unroll
            for (int qp = 0; qp < 8; ++qp) {
                int hl = h; asm volatile("" : "+v"(hl), "+v"(dep[(rb * 8 + qp) & 3]));
                const int p = 16 * rb + (qp & 1) + 4 * (qp >> 1) + 2 * hl; const f32x2 a5 = T[32 * 65 + p]; float c0 = 0.f, c1 = 0.f;
#pragma unroll
                for (int s7 = 0; s7 < 7; ++s7) { const f32x2 e = EX[(j + s7) * 64 + p];
                    const float nr = a5.x * c0 - a5.y * c1 + e.x, ni = a5.x * c1 + a5.y * c0 + e.y; c0 = nr; c1 = ni; }
                const f32x2 as = T[sp * 65 + p];
                x[rb][2 * qp] += as.x * c0 - as.y * c1; x[rb][2 * qp + 1] += as.x * c1 + as.y * c0; dep[(rb * 8 + qp) & 3] = x[rb][2 * qp];
                if (j == 7 && r == 31) { const f32x2 e = EX[14 * 64 + p]; F.out[O_SRP + (size_t)(b * 32 + g) * 64 + p] = e.x + a5.x * c0 - a5.y * c1; F.out[O_SIP + (size_t)(b * 32 + g) * 64 + p] = e.y + a5.x * c1 + a5.y * c0; }
            }
    }
    __syncthreads();
    asm volatile("" ::: "memory");
#pragma unroll
    for (int ks = 0; ks < 16; ++ks) uf[ks] = *(const bf16x8*)(UF + ((size_t)(((tok0 >> 9) * 32 + g) * 16 + ks) * 64 + lane) * 8);
    bf16x8 hf[4][2];
#pragma unroll
    for (int rb = 0; rb < 4; ++rb)
#pragma unroll
        for (int s2 = 0; s2 < 2; ++s2) { v4u w; w.x = pk2(x[rb][8 * s2 + 0], x[rb][8 * s2 + 1]); w.y = pk2(x[rb][8 * s2 + 2], x[rb][8 * s2 + 3]); w.z = pk2(x[rb][8 * s2 + 4], x[rb][8 * s2 + 5]); w.w = pk2(x[rb][8 * s2 + 6], x[rb][8 * s2 + 7]);
            hf[rb][s2] = __builtin_bit_cast(bf16x8, w); }
    ssm_step3(TZT, W3P, YS, uf, hf, g, lane, r, h, tok0);
}

#define XB_TMO      128
#define XB_XCNT(j)  (256  + 64 * (j))
#define XB_XSUB(j)  (1280 + 64 * (j))
#define XB_XGEN(j)  (2304 + 64 * (j))
#define XB_TOP      3328
#define XB_TOPGEN   3392
#define XCD_BAR_WORDS 3456
#define XB_SPIN_CAP (1u << 22)

__device__ __forceinline__ unsigned xb_ld(unsigned* p)              { return __hip_atomic_load(p, __ATOMIC_RELAXED, __HIP_MEMORY_SCOPE_AGENT); }
__device__ __forceinline__ unsigned xb_add(unsigned* p, unsigned v) { return __hip_atomic_fetch_add(p, v, __ATOMIC_RELAXED, __HIP_MEMORY_SCOPE_AGENT); }
__device__ __forceinline__ unsigned xb_xcc_id() { return (unsigned)__builtin_amdgcn_s_getreg((3 << 11) | 20) & 0xFu; }
#define XB_SPIN(cond, bar) do { unsigned _sp = 0; while (cond) { __builtin_amdgcn_s_sleep(1); \
    if ((++_sp & 255u) == 0u) { if (xb_ld(&(bar)[XB_TMO])) break; if (_sp > XB_SPIN_CAP) { atomicAdd(&(bar)[XB_TMO], 1u); break; } } } } while (0)

struct XcdBarrier {
    unsigned* bar; unsigned x;
    volatile LAS unsigned* st;
};

__device__ __forceinline__ XcdBarrier xcd_barrier_post(unsigned* bar, volatile LAS unsigned* st) {
    XcdBarrier b; b.bar = bar; b.x = xb_xcc_id(); b.st = st;
    if (threadIdx.x == 0) (void)xb_add(&bar[XB_XCNT(b.x)], 1u);
    return b;
}
__device__ __forceinline__ void xcd_barrier_complete(unsigned* bar, unsigned x, unsigned& nloc, unsigned& nx) {
    const unsigned G = gridDim.x * gridDim.y * gridDim.z;
    unsigned sum, cnt, mine, sp = 0u;
    for (;;) {
        sum = 0u; cnt = 0u; mine = 0u;
#pragma unroll
        for (unsigned j = 0; j < 16; ++j) { const unsigned c = xb_ld(&bar[XB_XCNT(j)]); sum += c; cnt += (c > 0u) ? 1u : 0u; mine = (j == x) ? c : mine; }
        if (sum == G) break;
        __builtin_amdgcn_s_sleep(1);
        if ((++sp & 255u) == 0u) { if (xb_ld(&bar[XB_TMO])) break; if (sp > XB_SPIN_CAP) { atomicAdd(&bar[XB_TMO], 1u); break; } }
    }
    nloc = mine > 0u ? mine : 1u; nx = cnt > 0u ? cnt : 1u;
}

__device__ __forceinline__ void xcd_barrier(const XcdBarrier& b) {
    asm volatile("s_waitcnt vmcnt(0)" ::: "memory");
    __syncthreads();
    if (threadIdx.x == 0) {
        unsigned* bar = b.bar;
        __builtin_amdgcn_s_waitcnt(0);
        unsigned nloc = b.st[0], nx = b.st[1];
        if (nloc == 0u) { xcd_barrier_complete(bar, b.x, nloc, nx); b.st[0] = nloc; b.st[1] = nx; }
        const unsigned old = xb_add(&bar[XB_XSUB(b.x)], 1u);
        const unsigned gen = old / nloc;
        if (old + 1u == (gen + 1u) * nloc) {
            __builtin_amdgcn_fence(__ATOMIC_RELEASE, "agent");
            asm volatile("s_waitcnt vmcnt(0)" ::: "memory");
            const unsigned og = xb_add(&bar[XB_TOP], 1u);
            const unsigned tg = og / nx;
            if (og + 1u == (tg + 1u) * nx) xb_add(&bar[XB_TOPGEN], 1u);
            else XB_SPIN(xb_ld(&bar[XB_TOPGEN]) == tg, bar);
            __builtin_amdgcn_fence(__ATOMIC_ACQUIRE, "agent");
            xb_add(&bar[XB_XGEN(b.x)], 1u);
            asm volatile("s_waitcnt vmcnt(0)" ::: "memory");
        } else {
            XB_SPIN(xb_ld(&bar[XB_XGEN(b.x)]) == gen, bar);
            __builtin_amdgcn_fence(__ATOMIC_ACQUIRE, "agent");
            asm volatile("s_waitcnt vmcnt(0)" ::: "memory");
        }
    }
    __syncthreads();
}

__global__ void __launch_bounds__(NTHR, 2) fwd_megakernel(Args args) {
    extern __shared__ __attribute__((aligned(16))) unsigned char lds[];
    cg::grid_group grid = cg::this_grid();
    Frame F;
    F.lds = (LAS unsigned char*)lds; F.tid = threadIdx.x; F.lane = F.tid & 63; F.wave = __builtin_amdgcn_readfirstlane(F.tid >> 6);
    F.G = gridDim.x; F.gw = blockIdx.x * NWAVES + F.wave; F.NGW = F.G * NWAVES; F.gt = blockIdx.x * NTHR + F.tid; F.NGT = F.G * NTHR;
    _Pragma("unroll") for (int i = 0; i < 27; ++i) F.in[i] = args.in[i];
    F.out = args.out; F.ws = args.ws;
    unsigned char* ws = args.ws;
    bf16* X0 = (bf16*)(ws + WS_X0); bf16* MIX = (bf16*)(ws + WS_MIX); bf16* YS = (bf16*)(ws + WS_YS); bf16* H = (bf16*)(ws + WS_H); bf16* ACT = (bf16*)(ws + WS_ACT);

    { volatile LAS unsigned* misc = (volatile LAS unsigned*)(F.lds + LDS_BYTES - 128); if (F.tid < 32) misc[F.tid] = 0u; }
    __syncthreads();
    const XcdBarrier bar = xcd_barrier_post((unsigned*)ws, (volatile LAS unsigned*)(F.lds + LDS_BYTES - 128));
#define REFRESH() do { int t_ = F.wave * 64 + pg8::lane_id_fresh(); F.tid = t_; F.lane = t_ & 63; F.gt = blockIdx.x * NTHR + t_; } while (0)
    for (int rep_ = 0; rep_ < REP_P0; ++rep_) {
    REFRESH();
    if (F.G >= 256) {
        const int v = blockIdx.x;
        if (v < 256) p1_group_prepare(F, v & 31);
        __syncthreads(); REFRESH();
        if (F.wave & 1) { p0b_stream(F); p0a_small(F); REFRESH(); if (v < 256) p1_tables(F, v & 31, v >> 5); }
        else { if (v < 256) p1_tables(F, v & 31, v >> 5); REFRESH(); p0b_stream(F); p0a_small(F); }
    } else {
        for (int v = blockIdx.x; v < 256; v += F.G) { p1_group_prepare(F, v & 31); __syncthreads(); p1_tables(F, v & 31, v >> 5); __syncthreads(); }
        REFRESH(); p0b_stream(F); p0a_small(F);
    }
    }
    if (F.G > 1000000) grid.sync();
    GSYNC();
    for (int rep_ = 0; rep_ < REP_P1; ++rep_) {
    REFRESH();
    { pg8::Gemm g{X0, (const bf16*)(ws + WS_WIN), M, NPROJ, D, D}; pg8::StaticOrder S; S.init(M, NPROJ, F.G, (int)blockIdx.x);
      EpiProj E{(bf16*)(ws + WS_QF), (bf16*)(ws + WS_UF), (bf16*)(ws + WS_KFP), (bf16*)(ws + WS_VFP), (bf16*)(ws + WS_KBS), (bf16*)(ws + WS_VTS), args.out};
      pg8::gemm_phase<EpiProj, pg8::StaticOrder, true, true>(F.lds, g, S, E, F.wave); }
    { const int nun = (M / 256) * (NPROJ / 256), first1 = nun > F.G ? nun - F.G : 0;
      REFRESH();
      if (first1 < F.G && (int)blockIdx.x >= first1) { for (int rw_ = 0; rw_ < REP_FFNW; ++rw_) p2_ffn_weights(F, ((int)blockIdx.x - first1) * NWAVES + F.wave, (F.G - first1) * NWAVES); }
      else if (first1 >= F.G) p2_ffn_weights(F, F.gw, F.NGW); }
    }
    GSYNC();
    for (int rep_ = 0; rep_ < REP_P2; ++rep_) {
    REFRESH();
    { const bool split = F.G >= 224;
      for (int rs_ = 0; rs_ < REP_SSMX; ++rs_)
      for (int u = blockIdx.x; u < 144; u += F.G) ssm_wg(F, u);
      REFRESH();
      for (int ra_ = 0; ra_ < REP_ATT; ++ra_) {
          if (!split) { for (int au = blockIdx.x; au < 576; au += F.G) attn_wave(F, au); }
          else if (blockIdx.x >= 144) for (int au = blockIdx.x - 144; au < ATT_SPLIT; au += F.G - 144) attn_wave(F, au); }
    }
    }
    GSYNC();
    for (int rep_ = 0; rep_ < REP_P4; ++rep_) {
    { pg8::Gemm g{YS, (const bf16*)(ws + WS_WGLU), M, SSMW, SSMW, SSMW}; pg8::StaticOrder S; S.init(M, SSMW, F.G, (int)blockIdx.x);
      EpiGlu E{YS, MIX, args.in[I_BGLU]};
      pg8::gemm_phase<EpiGlu, pg8::StaticOrder, true, true>(F.lds, g, S, E, F.wave); }
    if (F.G >= 224 && blockIdx.x >= 144) { REFRESH(); for (int au = ATT_SPLIT + (int)blockIdx.x - 144; au < 576; au += F.G - 144) attn_wave(F, au); }
    }
    GSYNC();
    for (int rep_ = 0; rep_ < REP_P5; ++rep_) {
    { pg8::Gemm g{MIX, (const bf16*)(ws + WS_WOUT), M, D, D, D}; MainTail S; S.init(F.G, (int)blockIdx.x, 16, 4, 4);
      EpiResTail E{X0, (bf16*)(ws + WS_PRE), (bf16*)(ws + WS_PART1) + (size_t)(blockIdx.x & 3) * MS * D};
      pg8::gemm_phase<EpiResTail, MainTail, true, true>(F.lds, g, S, E, F.wave); }
    }
    GSYNC();
    for (int rep_ = 0; rep_ < REP_P6; ++rep_) {
    REFRESH();
    for (int m = 4 * F.gw; m < MP; m += 4 * F.NGW) ln_rows4<true, true>((const bf16*)(ws + WS_PRE) + (size_t)m * D, D, args.in[I_L1G], args.in[I_L1B], H + (size_t)m * D, D, F.lane);
    for (int m = MP + F.gw; m < M; m += F.NGW) ln_row<true>(nullptr, args.in[I_L1G], args.in[I_L1B], H + (size_t)m * D, F.lane, (const bf16*)(ws + WS_PART1) + (size_t)(m - MP) * D, X0 + (size_t)m * D);
    }
    GSYNC();
    for (int rep_ = 0; rep_ < REP_P7; ++rep_) {
    { pg8::Gemm g{H, (const bf16*)(ws + WS_WGU), M, 2 * DFF, D, D}; pg8::StaticOrder S; S.init(M, 2 * DFF, F.G, (int)blockIdx.x);
      EpiSwiglu E{ACT};
      pg8::gemm_phase<EpiSwiglu, pg8::StaticOrder, true, true>(F.lds, g, S, E, F.wave); }
    }
    GSYNC();
    for (int rep_ = 0; rep_ < REP_P8; ++rep_) {
    { pg8::Gemm g{ACT, (const bf16*)(ws + WS_WDN), M, D, DFF, DFF}; MainTail S; S.init(F.G, (int)blockIdx.x, 44, 12, 10);
      EpiResTail E{H, (bf16*)(ws + WS_PRE), (bf16*)(ws + WS_PART2) + (size_t)(blockIdx.x & 3) * MS * D};
      pg8::gemm_phase<EpiResTail, MainTail, true, true>(F.lds, g, S, E, F.wave); }
    }
    GSYNC();
    for (int rep_ = 0; rep_ < REP_P9; ++rep_) {
    REFRESH();
    for (int m = 4 * F.gw; m < MP; m += 4 * F.NGW) ln_rows4<false, true>((const bf16*)(ws + WS_PRE) + (size_t)m * D, D, args.in[I_L2G], args.in[I_L2B], args.out + O_Y + (size_t)m * D, D, F.lane);
    for (int m = MP + F.gw; m < M; m += F.NGW) ln_row<false>(nullptr, args.in[I_L2G], args.in[I_L2B], args.out + O_Y + (size_t)m * D, F.lane, (const bf16*)(ws + WS_PART2) + (size_t)(m - MP) * D, H + (size_t)m * D);
    }
}

extern "C" void kernel_launch(void* const* d_in, const int* in_sizes, int n_in, void* d_out, int out_size, void* d_ws, size_t ws_size, hipStream_t stream) {
    static int grid = 0;
    if (grid == 0) {
        int dev = 0, cus = 0, per_cu = 0;
        hipGetDevice(&dev);
        hipDeviceGetAttribute(&cus, hipDeviceAttributeMultiprocessorCount, dev);
        hipFuncSetAttribute((const void*)fwd_megakernel, hipFuncAttributeMaxDynamicSharedMemorySize, LDS_BYTES);
        if (hipOccupancyMaxActiveBlocksPerMultiprocessor(&per_cu, (const void*)fwd_megakernel, NTHR, LDS_BYTES) != hipSuccess || per_cu < 1) per_cu = 1;
        (void)hipGetLastError();
        grid = cus * per_cu;
        if (n_in != 27 || ws_size < WS_END) { fprintf(stderr, "kernel_launch: unexpected n_in %d / ws %zu\n", n_in, ws_size); }
    }
    if (hipMemsetAsync(d_ws, 0, 16384, stream) != hipSuccess) { fprintf(stderr, "kernel_launch: hipMemsetAsync failed\n"); return; }
    Args a{};
    for (int i = 0; i < 27; ++i) a.in[i] = (const float*)d_in[i];
    a.out = (float*)d_out; a.ws = (unsigned char*)d_ws;
    void* kargs[] = {&a};
    hipError_t e = hipLaunchCooperativeKernel((const void*)fwd_megakernel, dim3(grid), dim3(NTHR), kargs, LDS_BYTES, stream);
    if (e != hipSuccess) fprintf(stderr, "cooperative launch failed: %s (grid %d)\n", hipGetErrorString(e), grid);
}
```

```cpp
#include <hip/hip_runtime.h>
#include <hip/hip_cooperative_groups.h>
#include <cstdio>
#include <cstdint>
namespace cg = cooperative_groups;
namespace pg8 {
#define PG8_LAS __attribute__((address_space(3)))
typedef unsigned short bf16_t;
typedef short bf16x8 __attribute__((ext_vector_type(8)));
typedef float f32x4 __attribute__((ext_vector_type(4)));
typedef unsigned u32x4 __attribute__((ext_vector_type(4)));
constexpr int BM = 256, BK = 64, HALF = 128, HTB = HALF * BK * 2  , STAGE_BYTES = 8 * HTB, NXCD = 8, WGM = 8;

__host__ __device__ __forceinline__ int lds_byte(int r, int c) { const int st = (r >> 4) * 2 + (c >> 5), rr = r & 15, cc = c & 31, ob = rr * 64 + cc * 2; return st * 1024 + (ob ^ (((ob >> 9) & 1) << 5)); }
__host__ __device__ __forceinline__ void stage_rc(int b, int& R, int& C) { const int st = b / 1024, sb = b % 1024, swz = sb ^ (((sb >> 9) & 1) << 5); R = (st >> 1) * 16 + swz / 64; C = (st & 1) * 32 + (swz % 64) / 2; }
__host__ __device__ __forceinline__ int perm32(int rho) { const int n = rho >> 4, i = rho & 15; return 8 * (i >> 2) + 4 * n + (i & 3); }

__device__ __forceinline__ int lane_id_fresh() { int l; asm volatile("v_mbcnt_lo_u32_b32 %0, -1, 0\n\tv_mbcnt_hi_u32_b32 %0, -1, %0" : "=v"(l)); return l; }
struct Unit { int pm, pn, k0t, nt; };
struct Gemm { const bf16_t* A; const bf16_t* Bt; int M, N, K, ld; };

struct StaticOrder {
    int nM, nN, nwg, G, c;
    __host__ __device__ __forceinline__ void init(int M, int N, int G_, int c_) { nM = M / BM; nN = N / BM; nwg = nM * nN; G = G_; c = c_; }
    __host__ __device__ __forceinline__ bool next(int i, Unit& u) const {
        const long L = (long)i * G + c; if (L >= nwg) return false;
        int wgid = (int)L; { const int q = nwg / NXCD, r = nwg % NXCD, xcd = wgid % NXCD, off = wgid / NXCD; wgid = (xcd < r ? xcd * (q + 1) : r * (q + 1) + (xcd - r) * q) + off; }
        const int nig = WGM * nN, gid = wgid / nig, fm = gid * WGM, gsz = (nM - fm) < WGM ? (nM - fm) : WGM;
        u.pm = fm + ((wgid % nig) % gsz); u.pn = (wgid % nig) / gsz; u.k0t = 0; u.nt = 0; return true;
    }
    __device__ __forceinline__ void a_ready(const Unit&) const {}
    __device__ __forceinline__ void done(const Unit&) const {}
};

__device__ __forceinline__ unsigned cvt_pk_bf16(float lo, float hi) { unsigned r; asm volatile("v_cvt_pk_bf16_f32 %0, %1, %2" : "=v"(r) : "v"(lo), "v"(hi)); return r; }
typedef float f32x2 __attribute__((ext_vector_type(2)));
__device__ __forceinline__ f32x2 gelu_pk(f32x2 v) {
    const f32x2 av = __builtin_elementwise_abs(v), d = av * 0.2316418882f + 1.0f;
    f32x2 t; t.x = __builtin_amdgcn_rcpf(d.x); t.y = __builtin_amdgcn_rcpf(d.y);
    f32x2 q = t * 0.5307027145f + (-0.7265760135f); q = q * t + 0.7107068705f; q = q * t + (-0.142248368f); q = q * t + 0.127414796f; q = q * t;
    const f32x2 s = (v * v) * (-0.72134752044f);
    f32x2 e; e.x = __builtin_amdgcn_exp2f(s.x); e.y = __builtin_amdgcn_exp2f(s.y);
    const f32x2 m = v * (q * e), r = v - m;
    f32x2 o; o.x = v.x < 0.f ? m.x : r.x; o.y = v.y < 0.f ? m.y : r.y; return o;
}

template <int ACT  > struct EpiBf16 {
    static constexpr bool PERM = true, AFTER_DRAIN = false; static_assert(ACT == 0 || ACT == 1, "EpiBf16: ACT is 0 (none) or 1 (gelu_pk)");
    bf16_t* O; int ldc; const float* bias; int split_cols; size_t split_stride; float scale0;
    __device__ __forceinline__ void operator()(const f32x4 (&acc)[2][2][4][2], const Unit& u, int wr, int wc, int fr, int fq) const {
        const int row0 = u.pm * BM + wr * 64 + fr; int colt = u.pn * BM; bf16_t* base = O;
        float sc = 1.f; if (split_cols) { const int t = colt / split_cols; base += (size_t)t * split_stride; colt -= t * split_cols; if (t == 0) sc = scale0; }
        const int col0 = colt + wc * 32 + 8 * fq, bcol0 = u.pn * BM + wc * 32 + 8 * fq;
        f32x4 bv[2][2];
#pragma unroll
        for (int bj = 0; bj < 2; ++bj)
#pragma unroll
            for (int n = 0; n < 2; ++n) bv[bj][n] = bias ? *(const f32x4*)(bias + bcol0 + bj * HALF + 4 * n) : (f32x4){0.f, 0.f, 0.f, 0.f};
#pragma unroll
        for (int ai = 0; ai < 2; ++ai)
#pragma unroll
            for (int m = 0; m < 4; ++m) { bf16_t* rowp = base + (size_t)(row0 + ai * HALF + m * 16) * ldc + col0;
#pragma unroll
                for (int bj = 0; bj < 2; ++bj) { f32x4 v0 = acc[ai][bj][m][0] + bv[bj][0], v1 = acc[ai][bj][m][1] + bv[bj][1];
                    if (ACT == 1) { f32x2 a = gelu_pk((f32x2){v0[0], v0[1]}), b = gelu_pk((f32x2){v0[2], v0[3]}), c = gelu_pk((f32x2){v1[0], v1[1]}), d = gelu_pk((f32x2){v1[2], v1[3]});
                        v0 = (f32x4){a.x, a.y, b.x, b.y}; v1 = (f32x4){c.x, c.y, d.x, d.y}; }
                    v0 = v0 * sc; v1 = v1 * sc; u32x4 w; w.x = cvt_pk_bf16(v0[0], v0[1]); w.y = cvt_pk_bf16(v0[2], v0[3]); w.z = cvt_pk_bf16(v1[0], v1[1]); w.w = cvt_pk_bf16(v1[2], v1[3]);
                    *(u32x4*)(rowp + bj * HALF) = w; } }
    }
};
template <class Epi, class Sched, bool ALIGN_EPI = false, bool SP2 = false>
__device__ __forceinline__ void gemm_phase(PG8_LAS unsigned char* lds, const Gemm g, const Sched& S, const Epi& E, const int wave_id) {
    int tid_ = wave_id * 64 + lane_id_fresh();
    const int tid = tid_, wid = __builtin_amdgcn_readfirstlane(tid >> 6), lane = tid & 63, wr = wid >> 2, wc = wid & 3, fr = lane & 15, fq = lane >> 4;
    const int K = g.ld, nt_full = g.K / BK;
    unsigned voffA[2], voffB[2];
#pragma unroll
    for (int i = 0; i < 2; ++i) { int R, C; stage_rc(tid * 16 + i * 8192, R, C); const int Rb = Epi::PERM ? ((R & ~31) + perm32(R & 31)) : R;
        voffA[i] = (unsigned)(R * K + C) * 2u; voffB[i] = (unsigned)(Rb * K + C) * 2u; }
    const size_t kstep = (size_t)(BK * 2);
    const size_t hstep = (size_t)HALF * K * 2;
    const size_t tstep = 2 * hstep;
    const unsigned ldsw = (unsigned)wid * 1024u;
    const int aoff = lds_byte(wr * 64 + fr, fq * 8), boff = lds_byte(wc * 32 + fr, fq * 8);
#define PG8_SA(b, h) (((b) * 2 + (h)) * HTB)
#define PG8_SB(b, h) ((4 + (b) * 2 + (h)) * HTB)
#define PG8_STAGE(bufoff, gbase, voff) do { _Pragma("unroll") for (int _i = 0; _i < 2; ++_i) \
        __builtin_amdgcn_global_load_lds((const unsigned*)((const char*)(gbase) + (voff)[_i]), (PG8_LAS unsigned*)(lds + (bufoff) + ldsw + _i * 8192), 16, 0, 0); } while (0)
#define PG8_LDA(dst, b, h) do { _Pragma("unroll") for (int m = 0; m < 4; ++m) _Pragma("unroll") for (int k = 0; k < 2; ++k) dst[m][k] = *(const PG8_LAS bf16x8*)(lds + PG8_SA(b, h) + aoff + m * 2048 + k * 1024); } while (0)
#define PG8_LDB(dst, b, h) do { _Pragma("unroll") for (int n = 0; n < 2; ++n) _Pragma("unroll") for (int k = 0; k < 2; ++k) dst[n][k] = *(const PG8_LAS bf16x8*)(lds + PG8_SB(b, h) + boff + n * 2048 + k * 1024); } while (0)
#define PG8_MMA(ai, bj, At, Bt) do { __builtin_amdgcn_s_setprio(1); _Pragma("unroll") for (int m = 0; m < 4; ++m) _Pragma("unroll") for (int n = 0; n < 2; ++n) _Pragma("unroll") for (int k = 0; k < 2; ++k) \
        acc[ai][bj][m][n] = __builtin_amdgcn_mfma_f32_16x16x32_bf16(Bt[n][k], At[m][k], acc[ai][bj][m][n], 0, 0, 0); __builtin_amdgcn_s_setprio(0); } while (0)
#define PG8_WAIT_V(n) asm volatile("s_waitcnt vmcnt(" #n ")" ::: "memory")
#define PG8_WAIT_L(n) asm volatile("s_waitcnt lgkmcnt(" #n ")" ::: "memory")
#define PG8_BAR __builtin_amdgcn_s_barrier()
#define PG8_SCHED __builtin_amdgcn_sched_barrier(0)
    Unit cur, nxt; int ui = 0;
    if (!S.next(0, cur)) return;
    f32x4 acc[2][2][4][2];
#pragma unroll
    for (int a = 0; a < 2; ++a)
#pragma unroll
        for (int b = 0; b < 2; ++b)
#pragma unroll
            for (int m = 0; m < 4; ++m)
#pragma unroll
                for (int n = 0; n < 2; ++n) acc[a][b][m][n] = (f32x4){0.f, 0.f, 0.f, 0.f};
    bf16x8 At[4][2], B0[2][2], B1[2][2];
    const char* cA = (const char*)g.A + (size_t)cur.pm * tstep + (size_t)cur.k0t * kstep; const char* cB = (const char*)g.Bt + (size_t)cur.pn * tstep + (size_t)cur.k0t * kstep;
    int nt = cur.nt ? cur.nt : nt_full;
    S.a_ready(cur);
    if constexpr (SP2) {
        PG8_STAGE(PG8_SB(0, 0), cB, voffB); PG8_STAGE(PG8_SB(0, 1), cB + hstep, voffB); PG8_STAGE(PG8_SA(0, 0), cA, voffA); PG8_STAGE(PG8_SA(0, 1), cA + hstep, voffA);
        if (wr == 1) PG8_BAR;
        PG8_WAIT_V(2); PG8_BAR;
        PG8_STAGE(PG8_SB(1, 0), cB + kstep, voffB); PG8_STAGE(PG8_SA(1, 0), cA + kstep, voffA); PG8_STAGE(PG8_SB(1, 1), cB + hstep + kstep, voffB);
        PG8_WAIT_V(6); PG8_BAR;
    } else {
        PG8_STAGE(PG8_SB(0, 0), cB, voffB); PG8_STAGE(PG8_SA(0, 0), cA, voffA); PG8_STAGE(PG8_SB(0, 1), cB + hstep, voffB); PG8_STAGE(PG8_SA(0, 1), cA + hstep, voffA);
        if (wr == 1) PG8_BAR;
        PG8_WAIT_V(4); PG8_BAR;
        PG8_STAGE(PG8_SB(1, 0), cB + kstep, voffB); PG8_STAGE(PG8_SA(1, 0), cA + kstep, voffA); PG8_STAGE(PG8_SB(1, 1), cB + hstep + kstep, voffB);
        PG8_WAIT_V(6); PG8_BAR;
    }
    for (;;) {
        const bool has_next = S.next(ui + 1, nxt);
        const char* nA = has_next ? (const char*)g.A + (size_t)nxt.pm * tstep + (size_t)nxt.k0t * kstep : cA; const char* nB = has_next ? (const char*)g.Bt + (size_t)nxt.pn * tstep + (size_t)nxt.k0t * kstep : cB;
        for (int t = 0; t < nt; t += 2) {
            const bool last = (t == nt - 2);
            const char* a1 = cA + (size_t)(t + 1) * kstep;
            const char* a2 = last ? nA : cA + (size_t)(t + 2) * kstep; const char* b2 = last ? nB : cB + (size_t)(t + 2) * kstep;
            const char* a3 = a2 + kstep; const char* b3 = b2 + kstep;
            if (last && has_next) S.a_ready(nxt);
            if constexpr (SP2) {
            PG8_LDB(B0, 0, 0); PG8_LDB(B1, 0, 1); PG8_SCHED; PG8_LDA(At, 0, 0); PG8_STAGE(PG8_SA(1, 1), a1 + hstep, voffA);
            PG8_WAIT_V(8); PG8_WAIT_L(0); PG8_BAR; PG8_MMA(0, 0, At, B0); PG8_MMA(0, 1, At, B1); PG8_BAR; PG8_SCHED;
            PG8_LDA(At, 0, 1); PG8_STAGE(PG8_SB(0, 0), b2, voffB); PG8_STAGE(PG8_SB(0, 1), b2 + hstep, voffB); PG8_STAGE(PG8_SA(0, 0), a2, voffA);
            PG8_WAIT_V(8); PG8_WAIT_L(0); PG8_BAR; PG8_MMA(1, 0, At, B0); PG8_MMA(1, 1, At, B1); PG8_BAR; PG8_SCHED;
            PG8_LDB(B0, 1, 0); PG8_LDB(B1, 1, 1); PG8_SCHED; PG8_LDA(At, 1, 0); PG8_STAGE(PG8_SA(0, 1), a2 + hstep, voffA);
            PG8_WAIT_V(8); PG8_WAIT_L(0); PG8_BAR; PG8_MMA(0, 0, At, B0); PG8_MMA(0, 1, At, B1); PG8_BAR; PG8_SCHED;
            PG8_LDA(At, 1, 1); PG8_STAGE(PG8_SB(1, 0), b3, voffB); PG8_STAGE(PG8_SB(1, 1), b3 + hstep, voffB); PG8_STAGE(PG8_SA(1, 0), a3, voffA);
            PG8_WAIT_V(8); PG8_WAIT_L(0); PG8_BAR; PG8_MMA(1, 0, At, B0); PG8_MMA(1, 1, At, B1); PG8_BAR; PG8_SCHED;
            } else {
            PG8_LDB(B0, 0, 0); PG8_SCHED; PG8_LDA(At, 0, 0); PG8_STAGE(PG8_SA(1, 1), a1 + hstep, voffA);
            PG8_WAIT_L(8); PG8_BAR; PG8_WAIT_L(0); PG8_MMA(0, 0, At, B0); PG8_BAR; PG8_SCHED;
            PG8_LDB(B1, 0, 1); PG8_STAGE(PG8_SB(0, 0), b2, voffB);
            PG8_BAR; PG8_WAIT_L(0); PG8_MMA(0, 1, At, B1); PG8_BAR;
            PG8_LDA(At, 0, 1); PG8_STAGE(PG8_SA(0, 0), a2, voffA);
            PG8_BAR; PG8_WAIT_L(0); PG8_MMA(1, 0, At, B0); PG8_BAR; PG8_SCHED;
            PG8_STAGE(PG8_SB(0, 1), b2 + hstep, voffB);
            PG8_WAIT_V(6); PG8_BAR; PG8_MMA(1, 1, At, B1); PG8_BAR;
            PG8_LDB(B0, 1, 0); PG8_SCHED; PG8_LDA(At, 1, 0); PG8_STAGE(PG8_SA(0, 1), a2 + hstep, voffA);
            PG8_WAIT_L(8); PG8_BAR; PG8_WAIT_L(0); PG8_MMA(0, 0, At, B0); PG8_BAR; PG8_SCHED;
            PG8_LDB(B1, 1, 1); PG8_STAGE(PG8_SB(1, 0), b3, voffB);
            PG8_BAR; PG8_WAIT_L(0); PG8_MMA(0, 1, At, B1); PG8_BAR;
            PG8_LDA(At, 1, 1); PG8_STAGE(PG8_SA(1, 0), a3, voffA);
            PG8_BAR; PG8_WAIT_L(0); PG8_MMA(1, 0, At, B0); PG8_BAR; PG8_SCHED;
            PG8_STAGE(PG8_SB(1, 1), b3 + hstep, voffB);
            PG8_WAIT_V(6); PG8_BAR; PG8_MMA(1, 1, At, B1); PG8_BAR;
            }
        }
        if constexpr (ALIGN_EPI) { if (wr == 0) PG8_BAR; }
        if constexpr (!Epi::AFTER_DRAIN) { E(acc, cur, wr, wc, fr, fq); S.done(cur); }
        if (!has_next) break;
#pragma unroll
        for (int a = 0; a < 2; ++a)
#pragma unroll
            for (int b = 0; b < 2; ++b)
#pragma unroll
                for (int m = 0; m < 4; ++m)
#pragma unroll
                    for (int n = 0; n < 2; ++n) acc[a][b][m][n] = (f32x4){0.f, 0.f, 0.f, 0.f};
        cur = nxt; cA = nA; cB = nB; ++ui; nt = cur.nt ? cur.nt : nt_full;
        if constexpr (ALIGN_EPI) { if (wr == 1) PG8_BAR; }
    }
    PG8_WAIT_V(0);
    if constexpr (!ALIGN_EPI) { if (wr == 0) PG8_BAR; }
    PG8_BAR;
    if constexpr (Epi::AFTER_DRAIN) { E.fused(acc, cur, wr, wc, fr, fq, lds, wid, lane); S.done(cur); }
#undef PG8_SA
#undef PG8_SB
#undef PG8_STAGE
#undef PG8_LDA
#undef PG8_LDB
#undef PG8_MMA
#undef PG8_WAIT_V
#undef PG8_WAIT_L
#undef PG8_BAR
#undef PG8_SCHED
}
}

#define GAS __attribute__((address_space(1)))
#define LAS __attribute__((address_space(3)))
typedef unsigned short bf16;
typedef unsigned v4u __attribute__((ext_vector_type(4)));
typedef unsigned v2u __attribute__((ext_vector_type(2)));
typedef float f32x4 __attribute__((ext_vector_type(4)));
typedef float f32x2 __attribute__((ext_vector_type(2)));
typedef float f32x16 __attribute__((ext_vector_type(16)));
typedef short bf16x8 __attribute__((ext_vector_type(8)));
typedef short s16x4 __attribute__((ext_vector_type(4)));
typedef __bf16 bf16x2_t __attribute__((ext_vector_type(2)));
#define MFMA32(a, b, c) __builtin_amdgcn_mfma_f32_32x32x16_bf16((a), (b), (c), 0, 0, 0)

constexpr int NWAVES = 8, NTHR = 512;
constexpr int MP = 16384, MS = 2048, M = MP + MS, D = 1024, NPROJ = 1280, DFF = 2816, SSMW = 512;
constexpr float LN_EPS = 1e-5f, DN_ALPHA = 1.189207115002721f;
constexpr size_t O_Y = 0, O_WKP = 18874368, O_WVP = 18939904, O_SRP = 19005440, O_SIP = 19013632, O_WKS = 19021824, O_WVS = 19546112, O_SRS = 20070400, O_SIS = 20135936;
constexpr size_t MiB = 1u << 20;
constexpr size_t WS_WIN = 1 * MiB, WS_WGLU = 4 * MiB, WS_WOUT = 5 * MiB, WS_WGU = 7 * MiB, WS_WDN = 18 * MiB;
constexpr size_t WS_W1T = 24 * MiB, WS_TZT = 26 * MiB, WS_W3P = 30 * MiB, WS_POW16 = 32 * MiB, WS_POWL = 32 * MiB + 640 * 1024, WS_E = 33 * MiB, WS_BBAR = 33 * MiB + 512 * 1024;
constexpr size_t WS_KBS = 38 * MiB, WS_VTS = 39 * MiB + 512 * 1024;
constexpr size_t WS_PRE = 214 * MiB;
constexpr size_t WS_PART1 = 114 * MiB, WS_PART2 = 78 * MiB;
constexpr size_t WS_QF = 114 * MiB, WS_UF = 132 * MiB, WS_KFP = 150 * MiB, WS_VFP = 154 * MiB;
constexpr size_t WS_H = 42 * MiB, WS_X0 = 78 * MiB, WS_PROJ = 114 * MiB, WS_MIX = 159 * MiB, WS_YS = 195 * MiB, WS_ACT = 114 * MiB, WS_END = 246 * MiB;
static_assert(WS_POW16 + 2048 * 33 * 8 <= WS_POWL && WS_POWL + 2048 * 17 * 8 <= WS_E && WS_E + 4 * 8 * 32 * 128 * 4 <= WS_BBAR && WS_BBAR + 32 * 64 * 16 * 8 <= WS_KBS, "ws map");
static_assert(WS_ACT + (size_t)M * DFF * 2 <= WS_END && WS_YS + (size_t)M * SSMW * 2 <= WS_END && WS_VFP + 4 * MiB <= WS_MIX && WS_MIX + (size_t)M * D * 2 <= WS_YS, "ws map 2");
constexpr int LDS_BYTES = 150528;

__device__ __forceinline__ unsigned pk2(float lo, float hi) { f32x2 v = {lo, hi}; bf16x2_t b = __builtin_convertvector(v, bf16x2_t); return __builtin_bit_cast(unsigned, b); }
__device__ __forceinline__ bf16 f2bf(float f) { return (bf16)(pk2(f, 0.f) & 0xffffu); }
__device__ __forceinline__ float bflo(unsigned w) { return __uint_as_float(w << 16); }
__device__ __forceinline__ float bfhi(unsigned w) { return __uint_as_float(w & 0xffff0000u); }
__device__ __forceinline__ float sigmoidf_(float x) { return __builtin_amdgcn_rcpf(1.0f + __builtin_amdgcn_exp2f(x * -1.44269504089f)); }
__device__ __forceinline__ unsigned swiglu_pk(float g0, float g1, float u0, float u1) {
    const f32x2 g = {g0, g1}, u = {u0, u1}; const f32x2 t = g * -1.44269504089f;
    f32x2 e; e.x = __builtin_amdgcn_exp2f(t.x); e.y = __builtin_amdgcn_exp2f(t.y);
    const f32x2 d = e + 1.0f; f32x2 r; r.x = __builtin_amdgcn_rcpf(d.x); r.y = __builtin_amdgcn_rcpf(d.y);
    const f32x2 o = (g * u) * r; return pk2(o.x, o.y);
}
__device__ __forceinline__ float wave_sum(float v) {
#pragma unroll
    for (int o = 1; o < 64; o <<= 1) v += __shfl_xor(v, o);
    return v;
}

struct Args { const float* in[27]; float* out; unsigned char* ws; };
enum { I_XP = 0, I_XS, I_CK, I_CV, I_SRE, I_SIM, I_LNG, I_LNB, I_WIN, I_SINK, I_LRE, I_LIM, I_LSTEP, I_BRE, I_BIM, I_CRE, I_CIM, I_DSK, I_WGLU, I_BGLU, I_WOUT, I_L1G, I_L1B, I_WGU, I_WDN, I_L2G, I_L2B };

using pg8::Unit; using pg8::HALF;
__device__ __forceinline__ int vf_off(int key, int d) {
    const int w = key & 31; return (((w >> 4) * 2 + (d >> 5)) * 64 + ((w >> 2) & 1) * 32 + (d & 31)) * 8 + 4 * ((w >> 3) & 1) + (w & 3);
}
struct EpiProj {
    static constexpr bool PERM = true, AFTER_DRAIN = false;
    bf16* QF; bf16* UF; bf16* KFp; bf16* VFp; bf16* KFs; bf16* VFs; float* out;
    __device__ __forceinline__ void operator()(const pg8::f32x4 (&acc)[2][2][4][2], const Unit& u, int wr, int wc, int fr, int fq) const {
        const int row0 = u.pm * 256 + wr * 64 + fr, colb = u.pn * 256 + wc * 32 + 8 * fq;
        if (u.pn != 2) {
#pragma unroll
            for (int ai = 0; ai < 2; ++ai)
#pragma unroll
                for (int m = 0; m < 4; ++m) { const int row = row0 + ai * HALF + m * 16;
#pragma unroll
                    for (int bj = 0; bj < 2; ++bj) { const pg8::f32x4 v0 = acc[ai][bj][m][0], v1 = acc[ai][bj][m][1]; const int col = colb + bj * HALF;
                        v4u w; w.x = pk2(v0[0], v0[1]); w.y = pk2(v0[2], v0[3]); w.z = pk2(v1[0], v1[1]); w.w = pk2(v1[2], v1[3]);
                        if (u.pn < 2) { const int head = col >> 6, d0 = col & 63;
                            *(v4u*)(QF + ((size_t)(((row >> 5) * 8 + head) * 4 + (d0 >> 4)) * 64 + ((d0 >> 3) & 1) * 32 + (row & 31)) * 8) = w; }
                        else { const int c8 = col - 768, g = c8 >> 4;
                            *(v4u*)(UF + ((size_t)(((row >> 9) * 32 + g) * 16 + (row & 15)) * 64 + ((c8 >> 3) & 1) * 32 + ((row & 511) >> 4)) * 8) = w; } } }
        } else {
            const int colk = wc * 32 + 8 * fq, kvh = colk >> 6, d0 = colk & 63;
#pragma unroll
            for (int ai = 0; ai < 2; ++ai)
#pragma unroll
                for (int m = 0; m < 4; ++m) { const int row = row0 + ai * HALF + m * 16;
                    int b, key, nb; bf16 *kf, *vf; float *ok, *ov; bool wout;
                    if (u.pm < 64) { b = row >> 12; key = row & 4095; nb = 128; kf = KFp; vf = VFp; wout = key >= 3968;
                        ok = out + O_WKP + (size_t)(b * 128 + (key - 3968)) * 128 + colk; ov = out + O_WVP + (size_t)(b * 128 + (key - 3968)) * 128 + colk; }
                    else { const int srow = row - MP; b = srow >> 6; const int t = srow & 63; key = 128 + t; nb = 6; kf = KFs; vf = VFs; wout = true;
                        ok = out + O_WKS + (size_t)(b * 128 + 64 + t) * 128 + colk; ov = out + O_WVS + (size_t)(b * 128 + 64 + t) * 128 + colk; }
                    const size_t blk = (size_t)((b * 2 + kvh) * nb + (key >> 5));
                    const pg8::f32x4 k0 = acc[ai][0][m][0], k1 = acc[ai][0][m][1];
                    v4u w; w.x = pk2(k0[0], k0[1]); w.y = pk2(k0[2], k0[3]); w.z = pk2(k1[0], k1[1]); w.w = pk2(k1[2], k1[3]);
                    *(v4u*)(kf + ((blk * 4 + (d0 >> 4)) * 64 + ((d0 >> 3) & 1) * 32 + (key & 31)) * 8) = w;
#pragma unroll
                    for (int n = 0; n < 2; ++n)
#pragma unroll
                        for (int e = 0; e < 4; ++e) vf[blk * 2048 + vf_off(key, d0 + 4 * n + e)] = f2bf(acc[ai][1][m][n][e]);
                    if (wout) {
#pragma unroll
                        for (int n = 0; n < 2; ++n) { *(pg8::f32x4*)(ok + 4 * n) = acc[ai][0][m][n]; *(pg8::f32x4*)(ov + 4 * n) = acc[ai][1][m][n]; } }
                }
        }
    }
};
struct EpiGlu {
    static constexpr bool PERM = true, AFTER_DRAIN = false;
    const bf16* YS; bf16* MIX; const float* bglu;
    __device__ __forceinline__ void operator()(const pg8::f32x4 (&acc)[2][2][4][2], const Unit& u, int wr, int wc, int fr, int fq) const {
        const int row0 = u.pm * 256 + wr * 64 + fr, colb = u.pn * 256 + wc * 32 + 8 * fq;
#pragma unroll
        for (int bj = 0; bj < 2; ++bj) { const int col = colb + bj * HALF;
            const pg8::f32x4 b0 = *(const pg8::f32x4*)(bglu + col), b1 = *(const pg8::f32x4*)(bglu + col + 4);
#pragma unroll
            for (int ai = 0; ai < 2; ++ai)
#pragma unroll
                for (int m = 0; m < 4; ++m) { const int row = row0 + ai * HALF + m * 16;
                    const v4u y = *(const v4u*)(YS + (size_t)row * SSMW + col);
                    const pg8::f32x4 v0 = acc[ai][bj][m][0] + b0, v1 = acc[ai][bj][m][1] + b1;
                    v4u w;
                    w.x = pk2(bflo(y.x) * sigmoidf_(v0[0]), bfhi(y.x) * sigmoidf_(v0[1])); w.y = pk2(bflo(y.y) * sigmoidf_(v0[2]), bfhi(y.y) * sigmoidf_(v0[3]));
                    w.z = pk2(bflo(y.z) * sigmoidf_(v1[0]), bfhi(y.z) * sigmoidf_(v1[1])); w.w = pk2(bflo(y.w) * sigmoidf_(v1[2]), bfhi(y.w) * sigmoidf_(v1[3]));
                    *(v4u*)(MIX + (size_t)row * D + 512 + col) = w; } }
    }
};
struct EpiRes {
    static constexpr bool PERM = false, AFTER_DRAIN = false;
    const bf16* R; float* out;
    __device__ __forceinline__ void operator()(const pg8::f32x4 (&acc)[2][2][4][2], const Unit& u, int wr, int wc, int fr, int fq) const {
        const int row0 = u.pm * 256 + wr * 64 + fr, colb = u.pn * 256 + wc * 32 + 4 * fq;
#pragma unroll
        for (int ai = 0; ai < 2; ++ai)
#pragma unroll
            for (int m = 0; m < 4; ++m) { const size_t off = (size_t)(row0 + ai * HALF + m * 16) * D + colb;
#pragma unroll
                for (int bj = 0; bj < 2; ++bj)
#pragma unroll
                    for (int n = 0; n < 2; ++n) { const v2u r = *(const v2u*)(R + off + bj * HALF + n * 16);
                        pg8::f32x4 o = acc[ai][bj][m][n];
                        o[0] += DN_ALPHA * bflo(r.x); o[1] += DN_ALPHA * bfhi(r.x); o[2] += DN_ALPHA * bflo(r.y); o[3] += DN_ALPHA * bfhi(r.y);
                        *(pg8::f32x4*)(out + off + bj * HALF + n * 16) = o; } }
    }
};
struct EpiSwiglu {
    static constexpr bool PERM = true, AFTER_DRAIN = false;
    bf16* ACT;
    __device__ __forceinline__ void operator()(const pg8::f32x4 (&acc)[2][2][4][2], const Unit& u, int wr, int wc, int fr, int fq) const {
        const int row0 = u.pm * 256 + wr * 64 + fr, col = u.pn * 128 + wc * 32 + 8 * fq;
#pragma unroll
        for (int ai = 0; ai < 2; ++ai)
#pragma unroll
            for (int m = 0; m < 4; ++m) { const int row = row0 + ai * HALF + m * 16;
                const pg8::f32x4 g0 = acc[ai][0][m][0], g1 = acc[ai][0][m][1], u0 = acc[ai][1][m][0], u1 = acc[ai][1][m][1];
                v4u w;
                w.x = swiglu_pk(g0[0], g0[1], u0[0], u0[1]); w.y = swiglu_pk(g0[2], g0[3], u0[2], u0[3]);
                w.z = swiglu_pk(g1[0], g1[1], u1[0], u1[1]); w.w = swiglu_pk(g1[2], g1[3], u1[2], u1[3]);
                *(v4u*)(ACT + (size_t)row * DFF + col) = w; }
    }
};

struct MainTail {
    pg8::StaticOrder S; int nmain, tpm, tpn, k0t, nt; bool has_tail;
    __device__ __forceinline__ void init(int G, int c, int nt_full, int split_nt0, int split_nt1) {
        S.init(MP, D, G, c); nmain = (S.nwg - c + G - 1) / G; if (nmain < 0) nmain = 0;
        has_tail = c < 128 && G >= 128; tpm = 64 + (c >> 4); tpn = (c >> 2) & 3; const int sp = c & 3;
        k0t = sp < 2 ? sp * split_nt0 : 2 * split_nt0 + (sp - 2) * split_nt1; nt = sp < 2 ? split_nt0 : split_nt1; (void)nt_full;
    }
    __device__ __forceinline__ bool next(int i, Unit& u) const { if (i < nmain) return S.next(i, u); if (i == nmain && has_tail) { u.pm = tpm; u.pn = tpn; u.k0t = k0t; u.nt = nt; return true; } return false; }
    __device__ __forceinline__ void a_ready(const Unit&) const {}
    __device__ __forceinline__ void done(const Unit&) const {}
};
struct EpiResTail {
    static constexpr bool PERM = true, AFTER_DRAIN = false;
    const bf16* R; bf16* out; bf16* P;
    __device__ __forceinline__ void operator()(const pg8::f32x4 (&acc)[2][2][4][2], const Unit& u, int wr, int wc, int fr, int fq) const {
        const int colb = u.pn * 256 + wc * 32 + 8 * fq;
        if (u.pm < 64) { const int row0 = u.pm * 256 + wr * 64 + fr;
#pragma unroll
            for (int ai = 0; ai < 2; ++ai)
#pragma unroll
                for (int m = 0; m < 4; ++m) { const size_t off = (size_t)(row0 + ai * HALF + m * 16) * D + colb;
#pragma unroll
                    for (int bj = 0; bj < 2; ++bj) { const v4u r = *(const v4u*)(R + off + bj * HALF);
                        const pg8::f32x4 a0 = acc[ai][bj][m][0], a1 = acc[ai][bj][m][1];
                        v4u w; w.x = pk2(a0[0] + DN_ALPHA * bflo(r.x), a0[1] + DN_ALPHA * bfhi(r.x)); w.y = pk2(a0[2] + DN_ALPHA * bflo(r.y), a0[3] + DN_ALPHA * bfhi(r.y));
                        w.z = pk2(a1[0] + DN_ALPHA * bflo(r.z), a1[1] + DN_ALPHA * bfhi(r.z)); w.w = pk2(a1[2] + DN_ALPHA * bflo(r.w), a1[3] + DN_ALPHA * bfhi(r.w));
                        *(v4u*)(out + off + bj * HALF) = w; } }
        } else { const int row0 = (u.pm - 64) * 256 + wr * 64 + fr;
#pragma unroll
            for (int ai = 0; ai < 2; ++ai)
#pragma unroll
                for (int m = 0; m < 4; ++m) { const size_t off = (size_t)(row0 + ai * HALF + m * 16) * D + colb;
#pragma unroll
                    for (int bj = 0; bj < 2; ++bj) { const pg8::f32x4 a0 = acc[ai][bj][m][0], a1 = acc[ai][bj][m][1];
                        v4u w; w.x = pk2(a0[0], a0[1]); w.y = pk2(a0[2], a0[3]); w.z = pk2(a1[0], a1[1]); w.w = pk2(a1[2], a1[3]);
                        *(v4u*)(P + off + bj * HALF) = w; } }
        }
    }
};

struct Frame {
    LAS unsigned char* lds; int tid, lane, wave, G, gw, NGW, gt, NGT;
    const float* in[27]; float* out; unsigned char* ws;
};

__device__ __forceinline__ void transpose_item(const float* W, int K, int N, bf16* WT, int k0, int sc0, int dr0, LAS float* scr, int lane) {
    float tv[32];
#pragma unroll
    for (int i = 0; i < 32; ++i) tv[i] = W[(size_t)(k0 + 2 * i + (lane >> 5)) * N + sc0 + (lane & 31)];
#pragma unroll
    for (int i = 0; i < 32; ++i) scr[(2 * i + (lane >> 5)) * 33 + (lane & 31)] = tv[i];
    asm volatile("s_waitcnt lgkmcnt(0)" ::: "memory");
    const int c = lane & 7;
#pragma unroll
    for (int j = 0; j < 4; ++j) { const int n = (lane >> 3) + 8 * j; const LAS float* s = scr + (8 * c) * 33 + n;
        v4u o; o.x = pk2(s[0 * 33], s[1 * 33]); o.y = pk2(s[2 * 33], s[3 * 33]); o.z = pk2(s[4 * 33], s[5 * 33]); o.w = pk2(s[6 * 33], s[7 * 33]);
        *(v4u*)(WT + (size_t)(dr0 + n) * K + k0 + 8 * c) = o; }
    asm volatile("s_waitcnt lgkmcnt(0)" ::: "memory");
}
template <bool TO_BF16>
__device__ __forceinline__ void ln_row(const float* xrow, const float* g, const float* b, void* orow, int lane, const bf16* part = nullptr, const bf16* resid = nullptr) {
    const f32x4* xr = (const f32x4*)xrow + lane;
    f32x4 v[4]; float s = 0.f;
    if (part) {
#pragma unroll
        for (int j = 0; j < 4; ++j) { const v2u* pr = (const v2u*)part + lane + 64 * j; const size_t ps = (size_t)MS * D / 4;
            const v2u rr = ((const v2u*)resid)[lane + 64 * j];
            const v2u p0 = pr[0], p1 = pr[ps], p2 = pr[2 * ps], p3 = pr[3 * ps];
            v[j] = (f32x4){(bflo(p0.x) + bflo(p1.x)) + (bflo(p2.x) + bflo(p3.x)), (bfhi(p0.x) + bfhi(p1.x)) + (bfhi(p2.x) + bfhi(p3.x)),
                           (bflo(p0.y) + bflo(p1.y)) + (bflo(p2.y) + bflo(p3.y)), (bfhi(p0.y) + bfhi(p1.y)) + (bfhi(p2.y) + bfhi(p3.y))};
            v[j].x += DN_ALPHA * bflo(rr.x); v[j].y += DN_ALPHA * bfhi(rr.x); v[j].z += DN_ALPHA * bflo(rr.y); v[j].w += DN_ALPHA * bfhi(rr.y);
            s += (v[j].x + v[j].y) + (v[j].z + v[j].w); }
    } else {
#pragma unroll
    for (int j = 0; j < 4; ++j) { v[j] = xr[64 * j]; s += (v[j].x + v[j].y) + (v[j].z + v[j].w); }
    }
    const float mean = wave_sum(s) * (1.f / D); float s2 = 0.f;
#pragma unroll
    for (int j = 0; j < 4; ++j) { v[j] = v[j] - mean; s2 += (v[j].x * v[j].x + v[j].y * v[j].y) + (v[j].z * v[j].z + v[j].w * v[j].w); }
    const float rstd = 1.f / sqrtf(wave_sum(s2) * (1.f / D) + LN_EPS);
#pragma unroll
    for (int j = 0; j < 4; ++j) { const f32x4 gg = ((const f32x4*)g)[lane + 64 * j], bb = ((const f32x4*)b)[lane + 64 * j];
        const f32x4 o = v[j] * rstd * gg + bb;
        if (TO_BF16) { v2u w; w.x = pk2(o.x, o.y); w.y = pk2(o.z, o.w); ((v2u*)orow)[lane + 64 * j] = w; }
        else ((f32x4*)orow)[lane + 64 * j] = o; }
}

template <bool TO_BF16, bool IN_BF16 = false>
__device__ __forceinline__ void ln_rows4(const void* xrow_, size_t xstride, const float* g, const float* b, void* orow, size_t ostride, int lane) {
    f32x4 v[4][4]; float s[4], s2[4];
#pragma unroll
    for (int i = 0; i < 4; ++i)
#pragma unroll
        for (int j = 0; j < 4; ++j) {
            if (IN_BF16) { const v2u w = ((const v2u*)((const bf16*)xrow_ + i * xstride))[lane + 64 * j]; v[i][j] = (f32x4){bflo(w.x), bfhi(w.x), bflo(w.y), bfhi(w.y)}; }
            else v[i][j] = __builtin_nontemporal_load((const f32x4*)((const float*)xrow_ + i * xstride) + lane + 64 * j); }
#pragma unroll
    for (int i = 0; i < 4; ++i) { s[i] = 0.f;
#pragma unroll
        for (int j = 0; j < 4; ++j) s[i] += (v[i][j].x + v[i][j].y) + (v[i][j].z + v[i][j].w); }
#pragma unroll
    for (int o = 1; o < 64; o <<= 1) {
#pragma unroll
        for (int i = 0; i < 4; ++i) s[i] += __shfl_xor(s[i], o); }
#pragma unroll
    for (int i = 0; i < 4; ++i) { const float mean = s[i] * (1.f / D); s2[i] = 0.f;
#pragma unroll
        for (int j = 0; j < 4; ++j) { v[i][j] = v[i][j] - mean; s2[i] += (v[i][j].x * v[i][j].x + v[i][j].y * v[i][j].y) + (v[i][j].z * v[i][j].z + v[i][j].w * v[i][j].w); } }
#pragma unroll
    for (int o = 1; o < 64; o <<= 1) {
#pragma unroll
        for (int i = 0; i < 4; ++i) s2[i] += __shfl_xor(s2[i], o); }
#pragma unroll
    for (int j = 0; j < 4; ++j) { const f32x4 gg = ((const f32x4*)g)[lane + 64 * j], bb = ((const f32x4*)b)[lane + 64 * j];
#pragma unroll
        for (int i = 0; i < 4; ++i) { const float rstd = 1.f / sqrtf(s2[i] * (1.f / D) + LN_EPS); const f32x4 o = v[i][j] * rstd * gg + bb;
            if (TO_BF16) { v2u w; w.x = pk2(o.x, o.y); w.y = pk2(o.z, o.w); ((v2u*)((bf16*)orow + i * ostride))[lane + 64 * j] = w; }
            else __builtin_nontemporal_store(o, (f32x4*)((float*)orow + i * ostride) + lane + 64 * j); } }
}
__device__ __forceinline__ void ssm_polar(const float* const (&in)[27], int g, int p, float k, float& re, float& im) {
    const float dt = expf(in[I_LSTEP][g]); const float lr = in[I_LRE][g * 64 + p], li = in[I_LIM][g * 64 + p];
    const float mag = expf(lr * dt * k);
    double ang = (double)li * (double)dt * (double)k; ang -= 6.283185307179586476925 * rint(ang * 0.15915494309189533577);
    const float a = (float)ang; re = mag * cosf(a); im = mag * sinf(a);
}

__device__ __forceinline__ void p2_ffn_weights(Frame& F, int wi, int nw, int lo = 0, int hi = 16 * 176 + 44 * 32) {
    LAS float* scr = (LAS float*)(F.lds + F.wave * 16384);
    constexpr int I_GU = 16 * 176, I_DN = 44 * 32;
    for (int it = lo + wi; it < hi; it += nw) {
        if (it < I_GU) { const int kb = it / 176, nb = it % 176, dr0 = 32 * nb, tile = dr0 >> 8, within = dr0 & 255;
            const int sc0 = within < 128 ? tile * 128 + within : DFF + tile * 128 + within - 128;
            transpose_item(F.in[I_WGU], D, 2 * DFF, (bf16*)(F.ws + WS_WGU), 64 * kb, sc0, dr0, scr, F.lane); }
        else { const int r = it - I_GU, kb = r / 32, nb = r % 32; transpose_item(F.in[I_WDN], DFF, D, (bf16*)(F.ws + WS_WDN), 64 * kb, 32 * nb, 32 * nb, scr, F.lane); }
    }
}
__device__ __forceinline__ void p0a_small(Frame& F) {
    const float* const (&in)[27] = F.in; unsigned char* ws = F.ws;
    for (int idx = F.gt; idx < 32 * 128 * 32; idx += F.NGT) {
        const int c4 = (idx & 31) * 4, r = (idx >> 5) & 127, bb = idx >> 12, kvh = c4 >> 6, d0 = c4 & 63;
        const f32x4 k = *(const f32x4*)(in[I_CK] + (size_t)(bb * 128 + r) * 128 + c4), v = *(const f32x4*)(in[I_CV] + (size_t)(bb * 128 + r) * 128 + c4);
        const size_t blk = (size_t)((bb * 2 + kvh) * 6 + (r >> 5));
        v2u w; w.x = pk2(k.x, k.y); w.y = pk2(k.z, k.w);
        *(v2u*)((bf16*)(ws + WS_KBS) + ((blk * 4 + (d0 >> 4)) * 64 + ((d0 >> 3) & 1) * 32 + (r & 31)) * 8 + (d0 & 7)) = w;
        bf16* vf = (bf16*)(ws + WS_VTS) + blk * 2048;
        vf[vf_off(r, d0)] = f2bf(v.x); vf[vf_off(r, d0 + 1)] = f2bf(v.y); vf[vf_off(r, d0 + 2)] = f2bf(v.z); vf[vf_off(r, d0 + 3)] = f2bf(v.w);
        if (r >= 64) { *(f32x4*)(F.out + O_WKS + (size_t)(bb * 128 + r - 64) * 128 + c4) = k; *(f32x4*)(F.out + O_WVS + (size_t)(bb * 128 + r - 64) * 128 + c4) = v; }
    }
}
__device__ __forceinline__ void p0b_stream(Frame& F) {
    const float* const (&in)[27] = F.in; unsigned char* ws = F.ws;
    LAS float* scr = (LAS float*)(F.lds + F.wave * 16384);
    constexpr int I_IN = 16 * 40, I_GLU = 8 * 16, I_OUT = 16 * 32, NITEMS = I_IN + I_GLU + I_OUT;
    for (int it = F.gw; it < NITEMS; it += F.NGW) {
        int r = it;
        if (r < I_IN) { const int kb = r / 40, nb = r % 40; transpose_item(in[I_WIN], D, NPROJ, (bf16*)(ws + WS_WIN), 64 * kb, 32 * nb, 32 * nb, scr, F.lane); continue; } r -= I_IN;
        if (r < I_OUT) { const int kb = r / 32, nb = r % 32; transpose_item(in[I_WOUT], D, D, (bf16*)(ws + WS_WOUT), 64 * kb, 32 * nb, 32 * nb, scr, F.lane); continue; } r -= I_OUT;
        { const int kb = r / 16, nb = r % 16; transpose_item(in[I_WGLU], SSMW, SSMW, (bf16*)(ws + WS_WGLU), 64 * kb, 32 * nb, 32 * nb, scr, F.lane); }
    }
    for (int m = 4 * F.gw; m < M; m += 4 * F.NGW) {
        const float* xrow = m < MP ? in[I_XP] + (size_t)m * D : in[I_XS] + (size_t)(m - MP) * D;
        ln_rows4<true>(xrow, D, in[I_LNG], in[I_LNB], (bf16*)(ws + WS_X0) + (size_t)m * D, D, F.lane);
    }
}

constexpr int LDS_BB = 131072, LDS_PL = 131072 + 8192;
__device__ __forceinline__ void p1_group_prepare(Frame& F, int g) {
    const float* const (&in)[27] = F.in;
    LAS f32x2* BB = (LAS f32x2*)(F.lds + LDS_BB); LAS f32x2* PL = (LAS f32x2*)(F.lds + LDS_PL);
    for (int e = F.tid; e < 64 * 17; e += NTHR) { float re, im; ssm_polar(in, g, e / 17, (float)(e % 17), re, im); PL[e] = (f32x2){re, im}; }
    for (int e = F.tid; e < 64 * 16; e += NTHR) { const int p = e >> 4, gp = g * 64 + p; float ar, ai; ssm_polar(in, g, p, 1.f, ar, ai);
        const float lr = in[I_LRE][gp], li = in[I_LIM][gp], nr = ar - 1.0f, ni = ai, den = lr * lr + li * li;
        const float fr = (nr * lr + ni * li) / den, fi = (ni * lr - nr * li) / den;
        const float br = in[I_BRE][gp * 16 + (e & 15)], bi = in[I_BIM][gp * 16 + (e & 15)];
        BB[e] = (f32x2){fr * br - fi * bi, fr * bi + fi * br}; }
}
__device__ __forceinline__ void p1_tables(Frame& F, int g, int part) {
    const float* const (&in)[27] = F.in; unsigned char* ws = F.ws;
    const LAS f32x2* BBAR = (const LAS f32x2*)(F.lds + LDS_BB); const LAS f32x2* POWL = (const LAS f32x2*)(F.lds + LDS_PL);
    bf16* TZT = (bf16*)(ws + WS_TZT); bf16* W1T = (bf16*)(ws + WS_W1T); bf16* W3P = (bf16*)(ws + WS_W3P);
    for (int li = part * 264 + F.tid; li < (part + 1) * 264; li += NTHR) { const int p = li / 33, n = li % 33; float re, im;
        ssm_polar(in, g, p, 16.f * (float)n, re, im); ((f32x2*)(ws + WS_POW16))[(g * 33 + n) * 64 + p] = (f32x2){re, im}; }
    for (int li = part * 992 + F.tid; li < (part + 1) * 992; li += NTHR) {
        const int cp = li & 15, c = (li >> 4) & 15, dl = (li >> 8) - 15;
#define TZ_OFF(t, s) ((((size_t)((g * 8 + ((t) >> 1)) * 16 + (s))) * 64 + (cp >> 3) * 32 + 16 * ((t) & 1) + c) * 8 + (cp & 7))
        if (dl < 0) { for (int t = 0; t <= 15 + dl; ++t) TZT[TZ_OFF(t, t - dl)] = 0; continue; }
        float acc = 0.f;
        for (int p = 0; p < 64; ++p) {
            const float cr = in[I_CRE][(g * 16 + c) * 64 + p], ci = in[I_CIM][(g * 16 + c) * 64 + p];
            const f32x2 bb = BBAR[p * 16 + cp], pw = POWL[p * 17 + dl];
            const float zr = bb.x * pw.x - bb.y * pw.y, zi = bb.x * pw.y + bb.y * pw.x;
            acc += cr * zr - ci * zi;
        }
        if (dl == 0 && c == cp) acc += in[I_DSK][g * 16 + c];
        const bf16 v = f2bf(acc);
        for (int s = 0; s <= 15 - dl; ++s) TZT[TZ_OFF(s + dl, s)] = v;
#undef TZ_OFF
    }
    for (int li = part * 128 + F.tid; li < (part + 1) * 128; li += NTHR) {
        const int s = li & 15, p = li >> 4; const f32x2 pw = POWL[p * 17 + 15 - s];
        unsigned wr_[8], wi_[8];
#pragma unroll
        for (int c2 = 0; c2 < 8; ++c2) { const f32x2 b0 = BBAR[p * 16 + 2 * c2], b1 = BBAR[p * 16 + 2 * c2 + 1];
            wr_[c2] = pk2(b0.x * pw.x - b0.y * pw.y, b1.x * pw.x - b1.y * pw.y); wi_[c2] = pk2(b0.x * pw.y + b0.y * pw.x, b1.x * pw.y + b1.y * pw.x); }
        const int pp = 2 * p, rbk = pp >> 5, rr = pp & 31;
        v4u* d0 = (v4u*)(W1T + ((size_t)((g * 4 + rbk) * 16 + s) * 64 + rr) * 8); v4u* d1 = (v4u*)(W1T + ((size_t)((g * 4 + rbk) * 16 + s) * 64 + rr + 1) * 8);
        d0[0] = (v4u){wr_[0], wr_[1], wr_[2], wr_[3]}; d0[32] = (v4u){wr_[4], wr_[5], wr_[6], wr_[7]};
        d1[0] = (v4u){wi_[0], wi_[1], wi_[2], wi_[3]}; d1[32] = (v4u){wi_[4], wi_[5], wi_[6], wi_[7]};
    }
    for (int li = part * 2048 + F.tid; li < (part + 1) * 2048; li += NTHR) {
        const int p = li & 63, row = li >> 6, t = row >> 4, c = row & 15;
        const float cr = in[I_CRE][(g * 16 + c) * 64 + p], ci = in[I_CIM][(g * 16 + c) * 64 + p]; const f32x2 pw = POWL[p * 17 + t + 1];
        const float zr = cr * pw.x - ci * pw.y, zi = cr * pw.y + ci * pw.x;
        const int pp = 2 * p, rb = pp >> 5, w = pp & 31;
        *(unsigned*)(W3P + ((size_t)((((g * 8 + (row >> 5)) * 4 + rb) * 2 + (w >> 4))) * 64 + ((w >> 2) & 1) * 32 + (row & 31)) * 8 + 4 * ((w >> 3) & 1) + (w & 3)) = pk2(zr, -zi);
    }
}

#ifndef REP_P0
#define REP_P0 1
#endif
#ifndef REP_P1
#define REP_P1 1
#endif
#ifndef REP_P2
#define REP_P2 1
#endif
#ifndef REP_P3
#define REP_P3 1
#endif
#ifndef REP_P4
#define REP_P4 1
#endif
#ifndef REP_P5
#define REP_P5 1
#endif
#ifndef REP_P6
#define REP_P6 1
#endif
#ifndef REP_P7
#define REP_P7 1
#endif
#ifndef REP_P8
#define REP_P8 1
#endif
#ifndef REP_P9
#define REP_P9 1
#endif
#ifndef REP_P1T
#define REP_P1T 1
#endif
#ifndef REP_S1
#define REP_S1 1
#endif
#ifndef REP_S3
#define REP_S3 1
#endif
#ifndef REP_FFNW
#define REP_FFNW 1
#endif
#ifndef REP_ATT
#define REP_ATT 1
#endif
#ifndef REP_SSMX
#define REP_SSMX 1
#endif
#ifndef REP_SYNC
#define REP_SYNC 1
#endif
#ifndef REP_SYNCCG
#define REP_SYNCCG 1
#endif
#define GSYNC_CG() do { for (int s_ = 0; s_ < REP_SYNCCG; ++s_) grid.sync(); } while (0)
#define GSYNC() do { for (int s_ = 0; s_ < REP_SYNC; ++s_) xcd_barrier(bar); } while (0)
#define PIN8(a) asm volatile("" : "+v"(a[0]), "+v"(a[1]), "+v"(a[2]), "+v"(a[3]), "+v"(a[4]), "+v"(a[5]), "+v"(a[6]), "+v"(a[7]))
__device__ __forceinline__ void attn_wave(Frame& F, int au) {
    bf16* MIX = (bf16*)(F.ws + WS_MIX);
    const int lane = F.lane, r = lane & 31, h = lane >> 5;
    const int cgl = au >> 1, kvh = au & 1, qh = F.wave >> 2, head = kvh * 4 + (F.wave & 3);
    int row0, kb0; const bf16* kf0; const bf16* vf0;
    if (cgl < 256) { const int b = cgl >> 6, c = cgl & 63; row0 = b * 4096 + c * 64 + qh * 32; kb0 = c >= 2 ? 0 : (c == 1 ? 2 : 4);
        const long blk = (long)(b * 2 + kvh) * 128 + (2 * c - 4);
        kf0 = (const bf16*)(F.ws + WS_KFP) + blk * 2048; vf0 = (const bf16*)(F.ws + WS_VFP) + blk * 2048;
    } else { const int b = cgl - 256; row0 = MP + b * 64 + qh * 32; kb0 = 0;
        const long blk = (long)(b * 2 + kvh) * 6;
        kf0 = (const bf16*)(F.ws + WS_KBS) + blk * 2048; vf0 = (const bf16*)(F.ws + WS_VTS) + blk * 2048; }
    bf16x8 qf[4];
#pragma unroll
    for (int kk = 0; kk < 4; ++kk) qf[kk] = *(const bf16x8*)((const bf16*)(F.ws + WS_QF) + ((size_t)(((row0 >> 5) * 8 + head) * 4 + kk) * 64 + lane) * 8);
    f32x16 s[6];
    { bf16x8 f[2][8];
#pragma unroll
      for (int i = 0; i < 8; ++i) { f[0][i] = (bf16x8){0, 0, 0, 0, 0, 0, 0, 0}; f[1][i] = f[0][i]; }
      if (kb0 == 0) {
#pragma unroll
          for (int i = 0; i < 8; ++i) f[0][i] = *(const bf16x8*)(kf0 + (i * 64 + lane) * 8); }
#pragma unroll
      for (int bt = 0; bt < 3; ++bt) {
          if (bt < 2 && 2 * (bt + 1) >= kb0) {
#pragma unroll
              for (int i = 0; i < 8; ++i) f[(bt + 1) & 1][i] = *(const bf16x8*)(kf0 + (((bt + 1) * 8 + i) * 64 + lane) * 8); }
          if (2 * bt >= kb0) {
              PIN8(f[bt & 1]);
#pragma unroll
              for (int k2 = 0; k2 < 2; ++k2) { f32x16 acc;
#pragma unroll
                  for (int i = 0; i < 16; ++i) acc[i] = 0.f;
#pragma unroll
                  for (int kk = 0; kk < 4; ++kk) acc = MFMA32(f[bt & 1][k2 * 4 + kk], qf[kk], acc);
#pragma unroll
                  for (int i = 0; i < 16; ++i) s[2 * bt + k2][i] = acc[i] * 0.125f; }
          } else {
#pragma unroll
              for (int k2 = 0; k2 < 2; ++k2)
#pragma unroll
                  for (int i = 0; i < 16; ++i) s[2 * bt + k2][i] = -1e30f;
          }
      } }
    const float sink = F.in[I_SINK][head];
    float mx = sink;
#pragma unroll
    for (int kb = 0; kb < 6; ++kb)
#pragma unroll
        for (int i = 0; i < 16; ++i) mx = fmaxf(mx, s[kb][i]);
    mx = fmaxf(mx, __shfl_xor(mx, 32));
    float l = 0.f;
#pragma unroll
    for (int kb = 0; kb < 6; ++kb)
#pragma unroll
        for (int i = 0; i < 16; ++i) { const float p = __expf(s[kb][i] - mx); s[kb][i] = p; l += p; }
    l += __shfl_xor(l, 32); l += __expf(sink - mx);
    f32x16 o[2];
#pragma unroll
    for (int i = 0; i < 16; ++i) { o[0][i] = 0.f; o[1][i] = 0.f; }
    { bf16x8 f[2][8];
#pragma unroll
      for (int i = 0; i < 8; ++i) { f[0][i] = (bf16x8){0, 0, 0, 0, 0, 0, 0, 0}; f[1][i] = f[0][i]; }
      if (kb0 == 0) {
#pragma unroll
          for (int i = 0; i < 8; ++i) f[0][i] = *(const bf16x8*)(vf0 + (i * 64 + lane) * 8); }
#pragma unroll
      for (int bt = 0; bt < 3; ++bt) {
          if (bt < 2 && 2 * (bt + 1) >= kb0) {
#pragma unroll
              for (int i = 0; i < 8; ++i) f[(bt + 1) & 1][i] = *(const bf16x8*)(vf0 + (((bt + 1) * 8 + i) * 64 + lane) * 8); }
          if (2 * bt >= kb0) {
              PIN8(f[bt & 1]);
#pragma unroll
              for (int k2 = 0; k2 < 2; ++k2)
#pragma unroll
                  for (int s2 = 0; s2 < 2; ++s2) { const int kb = 2 * bt + k2;
                      v4u pw; pw.x = pk2(s[kb][8 * s2 + 0], s[kb][8 * s2 + 1]); pw.y = pk2(s[kb][8 * s2 + 2], s[kb][8 * s2 + 3]); pw.z = pk2(s[kb][8 * s2 + 4], s[kb][8 * s2 + 5]); pw.w = pk2(s[kb][8 * s2 + 6], s[kb][8 * s2 + 7]);
                      const bf16x8 pf = __builtin_bit_cast(bf16x8, pw);
#pragma unroll
                      for (int db = 0; db < 2; ++db) o[db] = MFMA32(f[bt & 1][(k2 * 2 + s2) * 2 + db], pf, o[db]); }
          }
      } }
    const float inv = 1.0f / l;
#pragma unroll
    for (int db = 0; db < 2; ++db)
#pragma unroll
        for (int qq = 0; qq < 4; ++qq) { v2u w; w.x = pk2(o[db][4 * qq] * inv, o[db][4 * qq + 1] * inv); w.y = pk2(o[db][4 * qq + 2] * inv, o[db][4 * qq + 3] * inv);
            *(v2u*)(MIX + (size_t)(row0 + r) * D + head * 64 + 32 * db + 8 * qq + 4 * h) = w; }
}

template <int CTRL, int ROWMASK>
__device__ __forceinline__ float dppf(float v) { return __int_as_float(__builtin_amdgcn_update_dpp(0, __float_as_int(v), CTRL, ROWMASK, 0xf, false)); }
constexpr int SSM_T_BYTES = 17408;
constexpr int ATT_SPLIT = 352;
template <int B8>
__device__ __forceinline__ void ssm_rowblock(const bf16* TZT, const bf16* W3P, bf16* YS, const bf16x8 (&uf)[16], const bf16x8 (&hf)[4][2], int g, int lane, int r, int h, int tok0) {
    constexpr int NT = 2 * B8 + 2, N = NT + 8, NBT = (N + 7) / 8;
    f32x16 acc;
#pragma unroll
    for (int i = 0; i < 16; ++i) acc[i] = 0.f;
    const bf16* trow = TZT + ((size_t)(g * 8 + B8) * 16 * 64 + lane) * 8; const bf16* wrow = W3P + ((size_t)(g * 8 + B8) * 8 * 64 + lane) * 8;
    bf16x8 f[2][8];
#pragma unroll
    for (int i = 0; i < 8; ++i) { f[0][i] = (bf16x8){0, 0, 0, 0, 0, 0, 0, 0}; f[1][i] = f[0][i]; }
#pragma unroll
    for (int i = 0; i < 8; ++i) if (i < N) f[0][i] = i < NT ? *(const bf16x8*)(trow + i * 512) : *(const bf16x8*)(wrow + (i - NT) * 512);
#pragma unroll
    for (int bt = 0; bt < NBT; ++bt) {
#pragma unroll
        for (int i = 0; i < 8; ++i) { const int ix = (bt + 1) * 8 + i; if (ix < N) f[(bt + 1) & 1][i] = ix < NT ? *(const bf16x8*)(trow + ix * 512) : *(const bf16x8*)(wrow + (ix - NT) * 512); }
        PIN8(f[bt & 1]);
#pragma unroll
        for (int i = 0; i < 8; ++i) { const int ix = bt * 8 + i; if (ix < N) acc = MFMA32(f[bt & 1][i], ix < NT ? uf[ix < NT ? ix : 0] : hf[ix < NT ? 0 : (ix - NT) >> 1][(ix - NT) & 1], acc); }
    }
#pragma unroll
    for (int qq = 0; qq < 4; ++qq) { const int c0 = 8 * (qq & 1) + 4 * h, t = 2 * B8 + (qq >> 1);
        const pg8::f32x2 g0 = pg8::gelu_pk((pg8::f32x2){acc[4 * qq], acc[4 * qq + 1]}), g1 = pg8::gelu_pk((pg8::f32x2){acc[4 * qq + 2], acc[4 * qq + 3]});
        v2u w; w.x = pk2(g0.x, g0.y); w.y = pk2(g1.x, g1.y);
        *(v2u*)(YS + (size_t)(tok0 + 16 * r + t) * SSMW + 16 * g + c0) = w; }
}
__device__ __forceinline__ void ssm_step3(const bf16* TZT, const bf16* W3P, bf16* YS, const bf16x8 (&uf)[16], const bf16x8 (&hf)[4][2], int g, int lane, int r, int h, int tok0) {
    const bf16* tz = TZT + ((size_t)(g * 8) * 16 * 64 + lane) * 8; const bf16* w3 = W3P + ((size_t)(g * 8) * 8 * 64 + lane) * 8;
    bf16x8 fa[8], fb[8]; f32x16 acc;
#pragma unroll
    for (int i = 0; i < 16; ++i) acc[i] = 0.f;
#define S3_EPI(B8) { _Pragma("unroll") for (int qq = 0; qq < 4; ++qq) { const int c0 = 8 * (qq & 1) + 4 * h, t = 2 * (B8) + (qq >> 1); \
        const pg8::f32x2 g0 = pg8::gelu_pk((pg8::f32x2){acc[4 * qq], acc[4 * qq + 1]}), g1 = pg8::gelu_pk((pg8::f32x2){acc[4 * qq + 2], acc[4 * qq + 3]}); \
        v2u w; w.x = pk2(g0.x, g0.y); w.y = pk2(g1.x, g1.y); *(v2u*)(YS + (size_t)(tok0 + 16 * r + t) * SSMW + 16 * g + c0) = w; } \
        _Pragma("unroll") for (int k = 0; k < 16; ++k) acc[k] = 0.f; }
    fa[0] = *(const bf16x8*)(tz + 0); fa[1] = *(const bf16x8*)(tz + 512); fa[2] = *(const bf16x8*)(w3 + 0); fa[3] = *(const bf16x8*)(w3 + 512); fa[4] = *(const bf16x8*)(w3 + 1024); fa[5] = *(const bf16x8*)(w3 + 1536); fa[6] = *(const bf16x8*)(w3 + 2048); fa[7] = *(const bf16x8*)(w3 + 2560);
    fb[0] = *(const bf16x8*)(w3 + 3072); fb[1] = *(const bf16x8*)(w3 + 3584); fb[2] = *(const bf16x8*)(tz + 8192); fb[3] = *(const bf16x8*)(tz + 8704); fb[4] = *(const bf16x8*)(tz + 9216); fb[5] = *(const bf16x8*)(tz + 9728); fb[6] = *(const bf16x8*)(w3 + 4096); fb[7] = *(const bf16x8*)(w3 + 4608);
    PIN8(fa);
    acc = MFMA32(fa[0], uf[0], acc); acc = MFMA32(fa[1], uf[1], acc); acc = MFMA32(fa[2], hf[0][0], acc); acc = MFMA32(fa[3], hf[0][1], acc); acc = MFMA32(fa[4], hf[1][0], acc); acc = MFMA32(fa[5], hf[1][1], acc); acc = MFMA32(fa[6], hf[2][0], acc); acc = MFMA32(fa[7], hf[2][1], acc);
    fa[0] = *(const bf16x8*)(w3 + 5120); fa[1] = *(const bf16x8*)(w3 + 5632); fa[2] = *(const bf16x8*)(w3 + 6144); fa[3] = *(const bf16x8*)(w3 + 6656); fa[4] = *(const bf16x8*)(w3 + 7168); fa[5] = *(const bf16x8*)(w3 + 7680); fa[6] = *(const bf16x8*)(tz + 16384); fa[7] = *(const bf16x8*)(tz + 16896);
    PIN8(fb);
    acc = MFMA32(fb[0], hf[3][0], acc); acc = MFMA32(fb[1], hf[3][1], acc); S3_EPI(0) acc = MFMA32(fb[2], uf[0], acc); acc = MFMA32(fb[3], uf[1], acc); acc = MFMA32(fb[4], uf[2], acc); acc = MFMA32(fb[5], uf[3], acc); acc = MFMA32(fb[6], hf[0][0], acc); acc = MFMA32(fb[7], hf[0][1], acc);
    fb[0] = *(const bf16x8*)(tz + 17408); fb[1] = *(const bf16x8*)(tz + 17920); fb[2] = *(const bf16x8*)(tz + 18432); fb[3] = *(const bf16x8*)(tz + 18944); fb[4] = *(const bf16x8*)(w3 + 8192); fb[5] = *(const bf16x8*)(w3 + 8704); fb[6] = *(const bf16x8*)(w3 + 9216); fb[7] = *(const bf16x8*)(w3 + 9728);
    PIN8(fa);
    acc = MFMA32(fa[0], hf[1][0], acc); acc = MFMA32(fa[1], hf[1][1], acc); acc = MFMA32(fa[2], hf[2][0], acc); acc = MFMA32(fa[3], hf[2][1], acc); acc = MFMA32(fa[4], hf[3][0], acc); acc = MFMA32(fa[5], hf[3][1], acc); S3_EPI(1) acc = MFMA32(fa[6], uf[0], acc); acc = MFMA32(fa[7], uf[1], acc);
    fa[0] = *(const bf16x8*)(w3 + 10240); fa[1] = *(const bf16x8*)(w3 + 10752); fa[2] = *(const bf16x8*)(w3 + 11264); fa[3] = *(const bf16x8*)(w3 + 11776); fa[4] = *(const bf16x8*)(tz + 24576); fa[5] = *(const bf16x8*)(tz + 25088); fa[6] = *(const bf16x8*)(tz + 25600); fa[7] = *(const bf16x8*)(tz + 26112);
    PIN8(fb);
    acc = MFMA32(fb[0], uf[2], acc); acc = MFMA32(fb[1], uf[3], acc); acc = MFMA32(fb[2], uf[4], acc); acc = MFMA32(fb[3], uf[5], acc); acc = MFMA32(fb[4], hf[0][0], acc); acc = MFMA32(fb[5], hf[0][1], acc); acc = MFMA32(fb[6], hf[1][0], acc); acc = MFMA32(fb[7], hf[1][1], acc);
    fb[0] = *(const bf16x8*)(tz + 26624); fb[1] = *(const bf16x8*)(tz + 27136); fb[2] = *(const bf16x8*)(tz + 27648); fb[3] = *(const bf16x8*)(tz + 28160); fb[4] = *(const bf16x8*)(w3 + 12288); fb[5] = *(const bf16x8*)(w3 + 12800); fb[6] = *(const bf16x8*)(w3 + 13312); fb[7] = *(const bf16x8*)(w3 + 13824);
    PIN8(fa);
    acc = MFMA32(fa[0], hf[2][0], acc); acc = MFMA32(fa[1], hf[2][1], acc); acc = MFMA32(fa[2], hf[3][0], acc); acc = MFMA32(fa[3], hf[3][1], acc); S3_EPI(2) acc = MFMA32(fa[4], uf[0], acc); acc = MFMA32(fa[5], uf[1], acc); acc = MFMA32(fa[6], uf[2], acc); acc = MFMA32(fa[7], uf[3], acc);
    fa[0] = *(const bf16x8*)(w3 + 14336); fa[1] = *(const bf16x8*)(w3 + 14848); fa[2] = *(const bf16x8*)(w3 + 15360); fa[3] = *(const bf16x8*)(w3 + 15872); fa[4] = *(const bf16x8*)(tz + 32768); fa[5] = *(const bf16x8*)(tz + 33280); fa[6] = *(const bf16x8*)(tz + 33792); fa[7] = *(const bf16x8*)(tz + 34304);
    PIN8(fb);
    acc = MFMA32(fb[0], uf[4], acc); acc = MFMA32(fb[1], uf[5], acc); acc = MFMA32(fb[2], uf[6], acc); acc = MFMA32(fb[3], uf[7], acc); acc = MFMA32(fb[4], hf[0][0], acc); acc = MFMA32(fb[5], hf[0][1], acc); acc = MFMA32(fb[6], hf[1][0], acc); acc = MFMA32(fb[7], hf[1][1], acc);
    fb[0] = *(const bf16x8*)(tz + 34816); fb[1] = *(const bf16x8*)(tz + 35328); fb[2] = *(const bf16x8*)(tz + 35840); fb[3] = *(const bf16x8*)(tz + 36352); fb[4] = *(const bf16x8*)(tz + 36864); fb[5] = *(const bf16x8*)(tz + 37376); fb[6] = *(const bf16x8*)(w3 + 16384); fb[7] = *(const bf16x8*)(w3 + 16896);
    PIN8(fa);
    acc = MFMA32(fa[0], hf[2][0], acc); acc = MFMA32(fa[1], hf[2][1], acc); acc = MFMA32(fa[2], hf[3][0], acc); acc = MFMA32(fa[3], hf[3][1], acc); S3_EPI(3) acc = MFMA32(fa[4], uf[0], acc); acc = MFMA32(fa[5], uf[1], acc); acc = MFMA32(fa[6], uf[2], acc); acc = MFMA32(fa[7], uf[3], acc);
    fa[0] = *(const bf16x8*)(w3 + 17408); fa[1] = *(const bf16x8*)(w3 + 17920); fa[2] = *(const bf16x8*)(w3 + 18432); fa[3] = *(const bf16x8*)(w3 + 18944); fa[4] = *(const bf16x8*)(w3 + 19456); fa[5] = *(const bf16x8*)(w3 + 19968); fa[6] = *(const bf16x8*)(tz + 40960); fa[7] = *(const bf16x8*)(tz + 41472);
    PIN8(fb);
    acc = MFMA32(fb[0], uf[4], acc); acc = MFMA32(fb[1], uf[5], acc); acc = MFMA32(fb[2], uf[6], acc); acc = MFMA32(fb[3], uf[7], acc); acc = MFMA32(fb[4], uf[8], acc); acc = MFMA32(fb[5], uf[9], acc); acc = MFMA32(fb[6], hf[0][0], acc); acc = MFMA32(fb[7], hf[0][1], acc);
    fb[0] = *(const bf16x8*)(tz + 41984); fb[1] = *(const bf16x8*)(tz + 42496); fb[2] = *(const bf16x8*)(tz + 43008); fb[3] = *(const bf16x8*)(tz + 43520); fb[4] = *(const bf16x8*)(tz + 44032); fb[5] = *(const bf16x8*)(tz + 44544); fb[6] = *(const bf16x8*)(tz + 45056); fb[7] = *(const bf16x8*)(tz + 45568);
    PIN8(fa);
    acc = MFMA32(fa[0], hf[1][0], acc); acc = MFMA32(fa[1], hf[1][1], acc); acc = MFMA32(fa[2], hf[2][0], acc); acc = MFMA32(fa[3], hf[2][1], acc); acc = MFMA32(fa[4], hf[3][0], acc); acc = MFMA32(fa[5], hf[3][1], acc); S3_EPI(4) acc = MFMA32(fa[6], uf[0], acc); acc = MFMA32(fa[7], uf[1], acc);
    fa[0] = *(const bf16x8*)(tz + 46080); fa[1] = *(const bf16x8*)(tz + 46592); fa[2] = *(const bf16x8*)(w3 + 20480); fa[3] = *(const bf16x8*)(w3 + 20992); fa[4] = *(const bf16x8*)(w3 + 21504); fa[5] = *(const bf16x8*)(w3 + 22016); fa[6] = *(const bf16x8*)(w3 + 22528); fa[7] = *(const bf16x8*)(w3 + 23040);
    PIN8(fb);
    acc = MFMA32(fb[0], uf[2], acc); acc = MFMA32(fb[1], uf[3], acc); acc = MFMA32(fb[2], uf[4], acc); acc = MFMA32(fb[3], uf[5], acc); acc = MFMA32(fb[4], uf[6], acc); acc = MFMA32(fb[5], uf[7], acc); acc = MFMA32(fb[6], uf[8], acc); acc = MFMA32(fb[7], uf[9], acc);
    fb[0] = *(const bf16x8*)(w3 + 23552); fb[1] = *(const bf16x8*)(w3 + 24064); fb[2] = *(const bf16x8*)(tz + 49152); fb[3] = *(const bf16x8*)(tz + 49664); fb[4] = *(const bf16x8*)(tz + 50176); fb[5] = *(const bf16x8*)(tz + 50688); fb[6] = *(const bf16x8*)(tz + 51200); fb[7] = *(const bf16x8*)(tz + 51712);
    PIN8(fa);
    acc = MFMA32(fa[0], uf[10], acc); acc = MFMA32(fa[1], uf[11], acc); acc = MFMA32(fa[2], hf[0][0], acc); acc = MFMA32(fa[3], hf[0][1], acc); acc = MFMA32(fa[4], hf[1][0], acc); acc = MFMA32(fa[5], hf[1][1], acc); acc = MFMA32(fa[6], hf[2][0], acc); acc = MFMA32(fa[7], hf[2][1], acc);
    fa[0] = *(const bf16x8*)(tz + 52224); fa[1] = *(const bf16x8*)(tz + 52736); fa[2] = *(const bf16x8*)(tz + 53248); fa[3] = *(const bf16x8*)(tz + 53760); fa[4] = *(const bf16x8*)(tz + 54272); fa[5] = *(const bf16x8*)(tz + 54784); fa[6] = *(const bf16x8*)(tz + 55296); fa[7] = *(const bf16x8*)(tz + 55808);
    PIN8(fb);
    acc = MFMA32(fb[0], hf[3][0], acc); acc = MFMA32(fb[1], hf[3][1], acc); S3_EPI(5) acc = MFMA32(fb[2], uf[0], acc); acc = MFMA32(fb[3], uf[1], acc); acc = MFMA32(fb[4], uf[2], acc); acc = MFMA32(fb[5], uf[3], acc); acc = MFMA32(fb[6], uf[4], acc); acc = MFMA32(fb[7], uf[5], acc);
    fb[0] = *(const bf16x8*)(w3 + 24576); fb[1] = *(const bf16x8*)(w3 + 25088); fb[2] = *(const bf16x8*)(w3 + 25600); fb[3] = *(const bf16x8*)(w3 + 26112); fb[4] = *(const bf16x8*)(w3 + 26624); fb[5] = *(const bf16x8*)(w3 + 27136); fb[6] = *(const bf16x8*)(w3 + 27648); fb[7] = *(const bf16x8*)(w3 + 28160);
    PIN8(fa);
    acc = MFMA32(fa[0], uf[6], acc); acc = MFMA32(fa[1], uf[7], acc); acc = MFMA32(fa[2], uf[8], acc); acc = MFMA32(fa[3], uf[9], acc); acc = MFMA32(fa[4], uf[10], acc); acc = MFMA32(fa[5], uf[11], acc); acc = MFMA32(fa[6], uf[12], acc); acc = MFMA32(fa[7], uf[13], acc);
    fa[0] = *(const bf16x8*)(tz + 57344); fa[1] = *(const bf16x8*)(tz + 57856); fa[2] = *(const bf16x8*)(tz + 58368); fa[3] = *(const bf16x8*)(tz + 58880); fa[4] = *(const bf16x8*)(tz + 59392); fa[5] = *(const bf16x8*)(tz + 59904); fa[6] = *(const bf16x8*)(tz + 60416); fa[7] = *(const bf16x8*)(tz + 60928);
    PIN8(fb);
    acc = MFMA32(fb[0], hf[0][0], acc); acc = MFMA32(fb[1], hf[0][1], acc); acc = MFMA32(fb[2], hf[1][0], acc); acc = MFMA32(fb[3], hf[1][1], acc); acc = MFMA32(fb[4], hf[2][0], acc); acc = MFMA32(fb[5], hf[2][1], acc); acc = MFMA32(fb[6], hf[3][0], acc); acc = MFMA32(fb[7], hf[3][1], acc); S3_EPI(6)
    fb[0] = *(const bf16x8*)(tz + 61440); fb[1] = *(const bf16x8*)(tz + 61952); fb[2] = *(const bf16x8*)(tz + 62464); fb[3] = *(const bf16x8*)(tz + 62976); fb[4] = *(const bf16x8*)(tz + 63488); fb[5] = *(const bf16x8*)(tz + 64000); fb[6] = *(const bf16x8*)(tz + 64512); fb[7] = *(const bf16x8*)(tz + 65024);
    PIN8(fa);
    acc = MFMA32(fa[0], uf[0], acc); acc = MFMA32(fa[1], uf[1], acc); acc = MFMA32(fa[2], uf[2], acc); acc = MFMA32(fa[3], uf[3], acc); acc = MFMA32(fa[4], uf[4], acc); acc = MFMA32(fa[5], uf[5], acc); acc = MFMA32(fa[6], uf[6], acc); acc = MFMA32(fa[7], uf[7], acc);
    fa[0] = *(const bf16x8*)(w3 + 28672); fa[1] = *(const bf16x8*)(w3 + 29184); fa[2] = *(const bf16x8*)(w3 + 29696); fa[3] = *(const bf16x8*)(w3 + 30208); fa[4] = *(const bf16x8*)(w3 + 30720); fa[5] = *(const bf16x8*)(w3 + 31232); fa[6] = *(const bf16x8*)(w3 + 31744); fa[7] = *(const bf16x8*)(w3 + 32256);
    PIN8(fb);
    acc = MFMA32(fb[0], uf[8], acc); acc = MFMA32(fb[1], uf[9], acc); acc = MFMA32(fb[2], uf[10], acc); acc = MFMA32(fb[3], uf[11], acc); acc = MFMA32(fb[4], uf[12], acc); acc = MFMA32(fb[5], uf[13], acc); acc = MFMA32(fb[6], uf[14], acc); acc = MFMA32(fb[7], uf[15], acc);
    PIN8(fa);
    acc = MFMA32(fa[0], hf[0][0], acc); acc = MFMA32(fa[1], hf[0][1], acc); acc = MFMA32(fa[2], hf[1][0], acc); acc = MFMA32(fa[3], hf[1][1], acc); acc = MFMA32(fa[4], hf[2][0], acc); acc = MFMA32(fa[5], hf[2][1], acc); acc = MFMA32(fa[6], hf[3][0], acc); acc = MFMA32(fa[7], hf[3][1], acc); S3_EPI(7)
#undef S3_EPI
}
__device__ __forceinline__ void ssm_wg(Frame& F, int wgu) {
    const bf16* UF = (const bf16*)(F.ws + WS_UF); const bf16* W1T = (const bf16*)(F.ws + WS_W1T); const bf16* TZT = (const bf16*)(F.ws + WS_TZT); const bf16* W3P = (const bf16*)(F.ws + WS_W3P);
    const f32x2* POW16 = (const f32x2*)(F.ws + WS_POW16); bf16* YS = (bf16*)(F.ws + WS_YS);
    LAS f32x2* T = (LAS f32x2*)(F.lds + F.wave * SSM_T_BYTES);
    LAS f32x2* EX = (LAS f32x2*)(F.lds + 8 * SSM_T_BYTES);
    const int lane = F.lane, r = lane & 31, h = lane >> 5;
    const bool prompt = wgu < 128;
    int g, tok0, b = 0, q = 0; const int j = F.wave;
    if (prompt) { b = wgu >> 5; g = wgu & 31; tok0 = b * 4096 + j * 512; }
    else { const int s_ = (wgu - 128) * 8 + F.wave; g = s_ & 31; q = s_ >> 5; tok0 = MP + q * 512; }
    const int sp = prompt ? r : (r & 3);
    if (j < 7) EX[j * 64 + lane] = (f32x2){0.f, 0.f};
#pragma unroll 11
    for (int n = 0; n < 33; ++n) T[n * 65 + lane] = POW16[(size_t)(g * 33 + n) * 64 + lane];
    bf16x8 uf[16];
#pragma unroll
    for (int ks = 0; ks < 16; ++ks) uf[ks] = *(const bf16x8*)(UF + ((size_t)(((tok0 >> 9) * 32 + g) * 16 + ks) * 64 + lane) * 8);
    f32x16 x[4];
    for (int r1_ = 0; r1_ < REP_S1; ++r1_)
    { const bf16* w1 = W1T + ((size_t)(g * 4) * 16 * 64 + lane) * 8;
      bf16x8 f[2][8];
#pragma unroll
      for (int i = 0; i < 8; ++i) f[0][i] = *(const bf16x8*)(w1 + i * 512);
#pragma unroll
      for (int bt = 0; bt < 8; ++bt) { const int rb = bt >> 1;
          if ((bt & 1) == 0) {
#pragma unroll
              for (int i = 0; i < 16; ++i) x[rb][i] = 0.f; }
          if (bt < 7) {
#pragma unroll
              for (int i = 0; i < 8; ++i) f[(bt + 1) & 1][i] = *(const bf16x8*)(w1 + ((bt + 1) * 8 + i) * 512); }
          PIN8(f[bt & 1]);
#pragma unroll
          for (int i = 0; i < 8; ++i) x[rb] = MFMA32(f[bt & 1][i], uf[(bt & 1) * 8 + i], x[rb]); } }
    const int bb = 8 * q + (r >> 2);
    float dep[4] = {0.f, 0.f, 0.f, 0.f};
#pragma unroll
    for (int rb = 0; rb < 4; ++rb)
#pragma unroll
        for (int qp = 0; qp < 8; ++qp) {
            int hl = h; asm volatile("" : "+v"(hl), "+v"(dep[(rb * 8 + qp) & 3]));
            const int p = 16 * rb + (qp & 1) + 4 * (qp >> 1) + 2 * hl;
            const float xr = x[rb][2 * qp], xi = x[rb][2 * qp + 1];
            float zr = dppf<0x138, 0xf>(xr), zi = dppf<0x138, 0xf>(xi);
            if (sp == 0) { zr = 0.f; zi = 0.f; if (!prompt) { zr = F.in[I_SRE][(bb * 32 + g) * 64 + p]; zi = F.in[I_SIM][(bb * 32 + g) * 64 + p]; } }
#define SSM_LEVEL(d) { const f32x2 ad = T[(d) * 65 + p]; float pr = dppf<0x110 + (d), 0xf>(zr), pi = dppf<0x110 + (d), 0xf>(zi);     \
                if (!prompt && sp < (d)) { pr = 0.f; pi = 0.f; } zr += ad.x * pr - ad.y * pi; zi += ad.x * pi + ad.y * pr; }
            SSM_LEVEL(1) SSM_LEVEL(2)
            if (prompt) { SSM_LEVEL(4) SSM_LEVEL(8)
                const f32x2 am = T[((r & 15) + 1) * 65 + p]; const float br = dppf<0x142, 0xa>(zr), bi = dppf<0x142, 0xa>(zi);
                zr += am.x * br - am.y * bi; zi += am.x * bi + am.y * br; }
#undef SSM_LEVEL
            const f32x2 a1 = T[65 + p];
            const float er = a1.x * zr - a1.y * zi + xr, ei = a1.x * zi + a1.y * zr + xi;
            if (prompt) { if (r == 31) EX[(7 + j) * 64 + p] = (f32x2){er, ei}; }
            else if (sp == 3) { F.out[O_SRS + (size_t)(bb * 32 + g) * 64 + p] = er; F.out[O_SIS + (size_t)(bb * 32 + g) * 64 + p] = ei; }
            x[rb][2 * qp] = zr; x[rb][2 * qp + 1] = zi; dep[(rb * 8 + qp) & 3] = zr;
        }
    __syncthreads();
    if (prompt) {
#pragma unroll
        for (int rb = 0; rb < 4; ++rb)
#pragma unroll
            for (int qp = 0; qp < 8; ++qp) {
                int hl = h; asm volatile("" : "+v"(hl), "+v"(dep[(rb * 8 + qp) & 3]));
                const int p = 16 * rb + (qp & 1) + 4 * (qp >> 1) + 2 * hl; const f32x2 a5 = T[32 * 65 + p]; float c0 = 0.f, c1 = 0.f;
#pragma unroll
                for (int s7 = 0; s7 < 7; ++s7) { const f32x2 e = EX[(j + s7) * 64 + p];
                    const float nr = a5.x * c0 - a5.y * c1 + e.x, ni = a5.x * c1 + a5.y * c0 + e.y; c0 = nr; c1 = ni; }
                const f32x2 as = T[sp * 65 + p];
                x[rb][2 * qp] += as.x * c0 - as.y * c1; x[rb][2 * qp + 1] += as.x * c1 + as.y * c0; dep[(rb * 8 + qp) & 3] = x[rb][2 * qp];
                if (j == 7 && r == 31) { const f32x2 e = EX[14 * 64 + p]; F.out[O_SRP + (size_t)(b * 32 + g) * 64 + p] = e.x + a5.x * c0 - a5.y * c1; F.out[O_SIP + (size_t)(b * 32 + g) * 64 + p] = e.y + a5.x * c1 + a5.y * c0; }
            }
    }
    __syncthreads();
    asm volatile("" ::: "memory");
#pragma unroll
    for (int ks = 0; ks < 16; ++ks) uf[ks] = *(const bf16x8*)(UF + ((size_t)(((tok0 >> 9) * 32 + g) * 16 + ks) * 64 + lane) * 8);
    bf16x8 hf[4][2];
#pragma unroll
    for (int rb = 0; rb < 4; ++rb)
#pragma unroll
        for (int s2 = 0; s2 < 2; ++s2) { v4u w; w.x = pk2(x[rb][8 * s2 + 0], x[rb][8 * s2 + 1]); w.y = pk2(x[rb][8 * s2 + 2], x[rb][8 * s2 + 3]); w.z = pk2(x[rb][8 * s2 + 4], x[rb][8 * s2 + 5]); w.w = pk2(x[rb][8 * s2 + 6], x[rb][8 * s2 + 7]);
            hf[rb][s2] = __builtin_bit_cast(bf16x8, w); }
    ssm_step3(TZT, W3P, YS, uf, hf, g, lane, r, h, tok0);
}

#define XB_TMO      128
#define XB_XCNT(j)  (256  + 64 * (j))
#define XB_XSUB(j)  (1280 + 64 * (j))
#define XB_XGEN(j)  (2304 + 64 * (j))
#define XB_TOP      3328
#define XB_TOPGEN   3392
#define XCD_BAR_WORDS 3456
#define XB_SPIN_CAP (1u << 22)

__device__ __forceinline__ unsigned xb_ld(unsigned* p)              { return __hip_atomic_load(p, __ATOMIC_RELAXED, __HIP_MEMORY_SCOPE_AGENT); }
__device__ __forceinline__ unsigned xb_add(unsigned* p, unsigned v) { return __hip_atomic_fetch_add(p, v, __ATOMIC_RELAXED, __HIP_MEMORY_SCOPE_AGENT); }
__device__ __forceinline__ unsigned xb_xcc_id() { return (unsigned)__builtin_amdgcn_s_getreg((3 << 11) | 20) & 0xFu; }
#define XB_SPIN(cond, bar) do { unsigned _sp = 0; while (cond) { __builtin_amdgcn_s_sleep(1); \
    if ((++_sp & 255u) == 0u) { if (xb_ld(&(bar)[XB_TMO])) break; if (_sp > XB_SPIN_CAP) { atomicAdd(&(bar)[XB_TMO], 1u); break; } } } } while (0)

struct XcdBarrier {
    unsigned* bar; unsigned x;
    volatile LAS unsigned* st;
};

__device__ __forceinline__ XcdBarrier xcd_barrier_post(unsigned* bar, volatile LAS unsigned* st) {
    XcdBarrier b; b.bar = bar; b.x = xb_xcc_id(); b.st = st;
    if (threadIdx.x == 0) (void)xb_add(&bar[XB_XCNT(b.x)], 1u);
    return b;
}
__device__ __forceinline__ void xcd_barrier_complete(unsigned* bar, unsigned x, unsigned& nloc, unsigned& nx) {
    const unsigned G = gridDim.x * gridDim.y * gridDim.z;
    unsigned sum, cnt, mine, sp = 0u;
    for (;;) {
        sum = 0u; cnt = 0u; mine = 0u;
#pragma unroll
        for (unsigned j = 0; j < 16; ++j) { const unsigned c = xb_ld(&bar[XB_XCNT(j)]); sum += c; cnt += (c > 0u) ? 1u : 0u; mine = (j == x) ? c : mine; }
        if (sum == G) break;
        __builtin_amdgcn_s_sleep(1);
        if ((++sp & 255u) == 0u) { if (xb_ld(&bar[XB_TMO])) break; if (sp > XB_SPIN_CAP) { atomicAdd(&bar[XB_TMO], 1u); break; } }
    }
    nloc = mine > 0u ? mine : 1u; nx = cnt > 0u ? cnt : 1u;
}

__device__ __forceinline__ void xcd_barrier(const XcdBarrier& b) {
    asm volatile("s_waitcnt vmcnt(0)" ::: "memory");
    __syncthreads();
    if (threadIdx.x == 0) {
        unsigned* bar = b.bar;
        __builtin_amdgcn_s_waitcnt(0);
        unsigned nloc = b.st[0], nx = b.st[1];
        if (nloc == 0u) { xcd_barrier_complete(bar, b.x, nloc, nx); b.st[0] = nloc; b.st[1] = nx; }
        const unsigned old = xb_add(&bar[XB_XSUB(b.x)], 1u);
        const unsigned gen = old / nloc;
        if (old + 1u == (gen + 1u) * nloc) {
            __builtin_amdgcn_fence(__ATOMIC_RELEASE, "agent");
            asm volatile("s_waitcnt vmcnt(0)" ::: "memory");
            const unsigned og = xb_add(&bar[XB_TOP], 1u);
            const unsigned tg = og / nx;
            if (og + 1u == (tg + 1u) * nx) xb_add(&bar[XB_TOPGEN], 1u);
            else XB_SPIN(xb_ld(&bar[XB_TOPGEN]) == tg, bar);
            __builtin_amdgcn_fence(__ATOMIC_ACQUIRE, "agent");
            xb_add(&bar[XB_XGEN(b.x)], 1u);
            asm volatile("s_waitcnt vmcnt(0)" ::: "memory");
        } else {
            XB_SPIN(xb_ld(&bar[XB_XGEN(b.x)]) == gen, bar);
            __builtin_amdgcn_fence(__ATOMIC_ACQUIRE, "agent");
            asm volatile("s_waitcnt vmcnt(0)" ::: "memory");
        }
    }
    __syncthreads();
}

__global__ void __launch_bounds__(NTHR, 2) fwd_megakernel(Args args) {
    extern __shared__ __attribute__((aligned(16))) unsigned char lds[];
    cg::grid_group grid = cg::this_grid();
    Frame F;
    F.lds = (LAS unsigned char*)lds; F.tid = threadIdx.x; F.lane = F.tid & 63; F.wave = __builtin_amdgcn_readfirstlane(F.tid >> 6);
    F.G = gridDim.x; F.gw = blockIdx.x * NWAVES + F.wave; F.NGW = F.G * NWAVES; F.gt = blockIdx.x * NTHR + F.tid; F.NGT = F.G * NTHR;
    _Pragma("unroll") for (int i = 0; i < 27; ++i) F.in[i] = args.in[i];
    F.out = args.out; F.ws = args.ws;
    unsigned char* ws = args.ws;
    bf16* X0 = (bf16*)(ws + WS_X0); bf16* MIX = (bf16*)(ws + WS_MIX); bf16* YS = (bf16*)(ws + WS_YS); bf16* H = (bf16*)(ws + WS_H); bf16* ACT = (bf16*)(ws + WS_ACT);

    { volatile LAS unsigned* misc = (volatile LAS unsigned*)(F.lds + LDS_BYTES - 128); if (F.tid < 32) misc[F.tid] = 0u; }
    __syncthreads();
    const XcdBarrier bar = xcd_barrier_post((unsigned*)ws, (volatile LAS unsigned*)(F.lds + LDS_BYTES - 128));
#define REFRESH() do { int t_ = F.wave * 64 + pg8::lane_id_fresh(); F.tid = t_; F.lane = t_ & 63; F.gt = blockIdx.x * NTHR + t_; } while (0)
    for (int rep_ = 0; rep_ < REP_P0; ++rep_) {
    REFRESH();
    if (F.G >= 256) {
        const int v = blockIdx.x;
        if (v < 256) p1_group_prepare(F, v & 31);
        __syncthreads(); REFRESH();
        if (F.wave & 1) { p0b_stream(F); p0a_small(F); REFRESH(); if (v < 256) p1_tables(F, v & 31, v >> 5); }
        else { if (v < 256) p1_tables(F, v & 31, v >> 5); REFRESH(); p0b_stream(F); p0a_small(F); }
    } else {
        for (int v = blockIdx.x; v < 256; v += F.G) { p1_group_prepare(F, v & 31); __syncthreads(); p1_tables(F, v & 31, v >> 5); __syncthreads(); }
        REFRESH(); p0b_stream(F); p0a_small(F);
    }
    }
    if (F.G > 1000000) grid.sync();
    GSYNC();
    for (int rep_ = 0; rep_ < REP_P1; ++rep_) {
    REFRESH();
    { pg8::Gemm g{X0, (const bf16*)(ws + WS_WIN), M, NPROJ, D, D}; pg8::StaticOrder S; S.init(M, NPROJ, F.G, (int)blockIdx.x);
      EpiProj E{(bf16*)(ws + WS_QF), (bf16*)(ws + WS_UF), (bf16*)(ws + WS_KFP), (bf16*)(ws + WS_VFP), (bf16*)(ws + WS_KBS), (bf16*)(ws + WS_VTS), args.out};
      pg8::gemm_phase<EpiProj, pg8::StaticOrder, true, true>(F.lds, g, S, E, F.wave); }
    { const int nun = (M / 256) * (NPROJ / 256), first1 = nun > F.G ? nun - F.G : 0;
      REFRESH();
      if (first1 < F.G && (int)blockIdx.x >= first1) { for (int rw_ = 0; rw_ < REP_FFNW; ++rw_) p2_ffn_weights(F, ((int)blockIdx.x - first1) * NWAVES + F.wave, (F.G - first1) * NWAVES, 0, 16 * 176); }
      else if (first1 >= F.G) p2_ffn_weights(F, F.gw, F.NGW, 0, 16 * 176); }
    }
    GSYNC();
    for (int rep_ = 0; rep_ < REP_P2; ++rep_) {
    REFRESH();
    { const bool split = F.G >= 224;
      for (int rs_ = 0; rs_ < REP_SSMX; ++rs_)
      for (int u = blockIdx.x; u < 144; u += F.G) ssm_wg(F, u);
      REFRESH();
      for (int ra_ = 0; ra_ < REP_ATT; ++ra_) {
          if (!split) { for (int au = blockIdx.x; au < 576; au += F.G) attn_wave(F, au); }
          else if (blockIdx.x >= 144) for (int au = blockIdx.x - 144; au < ATT_SPLIT; au += F.G - 144) attn_wave(F, au); }
    }
    }
    GSYNC();
    for (int rep_ = 0; rep_ < REP_P4; ++rep_) {
    { pg8::Gemm g{YS, (const bf16*)(ws + WS_WGLU), M, SSMW, SSMW, SSMW}; pg8::StaticOrder S; S.init(M, SSMW, F.G, (int)blockIdx.x);
      EpiGlu E{YS, MIX, args.in[I_BGLU]};
      pg8::gemm_phase<EpiGlu, pg8::StaticOrder, true, true>(F.lds, g, S, E, F.wave); }
    if (F.G >= 224 && blockIdx.x >= 144) { REFRESH(); for (int au = ATT_SPLIT + (int)blockIdx.x - 144; au < 576; au += F.G - 144) attn_wave(F, au); }
    }
    GSYNC();
    for (int rep_ = 0; rep_ < REP_P5; ++rep_) {
    { pg8::Gemm g{MIX, (const bf16*)(ws + WS_WOUT), M, D, D, D}; MainTail S; S.init(F.G, (int)blockIdx.x, 16, 4, 4);
      EpiResTail E{X0, (bf16*)(ws + WS_PRE), (bf16*)(ws + WS_PART1) + (size_t)(blockIdx.x & 3) * MS * D};
      pg8::gemm_phase<EpiResTail, MainTail, true, true>(F.lds, g, S, E, F.wave); }
    }
    GSYNC();
    for (int rep_ = 0; rep_ < REP_P6; ++rep_) {
    REFRESH();
    for (int m = 4 * F.gw; m < MP; m += 4 * F.NGW) ln_rows4<true, true>((const bf16*)(ws + WS_PRE) + (size_t)m * D, D, args.in[I_L1G], args.in[I_L1B], H + (size_t)m * D, D, F.lane);
    for (int m = MP + F.gw; m < M; m += F.NGW) ln_row<true>(nullptr, args.in[I_L1G], args.in[I_L1B], H + (size_t)m * D, F.lane, (const bf16*)(ws + WS_PART1) + (size_t)(m - MP) * D, X0 + (size_t)m * D);
    }
    GSYNC();
    for (int rep_ = 0; rep_ < REP_P7; ++rep_) {
    { pg8::Gemm g{H, (const bf16*)(ws + WS_WGU), M, 2 * DFF, D, D}; pg8::StaticOrder S; S.init(M, 2 * DFF, F.G, (int)blockIdx.x);
      EpiSwiglu E{ACT};
      pg8::gemm_phase<EpiSwiglu, pg8::StaticOrder, true, true>(F.lds, g, S, E, F.wave); }
    { const int nun = (M / 256) * (2 * DFF / 256), rem = nun % F.G;
      REFRESH();
      if (rem > 0 && (int)blockIdx.x >= rem) p2_ffn_weights(F, ((int)blockIdx.x - rem) * NWAVES + F.wave, (F.G - rem) * NWAVES, 16 * 176, 16 * 176 + 44 * 32);
      else if (rem == 0) p2_ffn_weights(F, F.gw, F.NGW, 16 * 176, 16 * 176 + 44 * 32); }
    }
    GSYNC();
    for (int rep_ = 0; rep_ < REP_P8; ++rep_) {
    { pg8::Gemm g{ACT, (const bf16*)(ws + WS_WDN), M, D, DFF, DFF}; MainTail S; S.init(F.G, (int)blockIdx.x, 44, 12, 10);
      EpiResTail E{H, (bf16*)(ws + WS_PRE), (bf16*)(ws + WS_PART2) + (size_t)(blockIdx.x & 3) * MS * D};
      pg8::gemm_phase<EpiResTail, MainTail, true, true>(F.lds, g, S, E, F.wave); }
    }
    GSYNC();
    for (int rep_ = 0; rep_ < REP_P9; ++rep_) {
    REFRESH();
    for (int m = 4 * F.gw; m < MP; m += 4 * F.NGW) ln_rows4<false, true>((const bf16*)(ws + WS_PRE) + (size_t)m * D, D, args.in[I_L2G], args.in[I_L2B], args.out + O_Y + (size_t)m * D, D, F.lane);
    for (int m = MP + F.gw; m < M; m += F.NGW) ln_row<false>(nullptr, args.in[I_L2G], args.in[I_L2B], args.out + O_Y + (size_t)m * D, F.lane, (const bf16*)(ws + WS_PART2) + (size_t)(m - MP) * D, H + (size_t)m * D);
    }
}

extern "C" void kernel_launch(void* const* d_in, const int* in_sizes, int n_in, void* d_out, int out_size, void* d_ws, size_t ws_size, hipStream_t stream) {
    static int grid = 0;
    if (grid == 0) {
        int dev = 0, cus = 0, per_cu = 0;
        hipGetDevice(&dev);
        hipDeviceGetAttribute(&cus, hipDeviceAttributeMultiprocessorCount, dev);
        hipFuncSetAttribute((const void*)fwd_megakernel, hipFuncAttributeMaxDynamicSharedMemorySize, LDS_BYTES);
        if (hipOccupancyMaxActiveBlocksPerMultiprocessor(&per_cu, (const void*)fwd_megakernel, NTHR, LDS_BYTES) != hipSuccess || per_cu < 1) per_cu = 1;
        (void)hipGetLastError();
        grid = cus * per_cu;
        if (n_in != 27 || ws_size < WS_END) { fprintf(stderr, "kernel_launch: unexpected n_in %d / ws %zu\n", n_in, ws_size); }
    }
    if (hipMemsetAsync(d_ws, 0, 16384, stream) != hipSuccess) { fprintf(stderr, "kernel_launch: hipMemsetAsync failed\n"); return; }
    Args a{};
    for (int i = 0; i < 27; ++i) a.in[i] = (const float*)d_in[i];
    a.out = (float*)d_out; a.ws = (unsigned char*)d_ws;
    void* kargs[] = {&a};
    hipError_t e = hipLaunchCooperativeKernel((const void*)fwd_megakernel, dim3(grid), dim3(NTHR), kargs, LDS_BYTES, stream);
    if (e != hipSuccess) fprintf(stderr, "cooperative launch failed: %s (grid %d)\n", hipGetErrorString(e), grid);
}
```

```cpp
#include <hip/hip_runtime.h>
#include <hip/hip_cooperative_groups.h>
#include <cstdio>
#include <cstdint>
namespace cg = cooperative_groups;
namespace pg8 {
#define PG8_LAS __attribute__((address_space(3)))
typedef unsigned short bf16_t;
typedef short bf16x8 __attribute__((ext_vector_type(8)));
typedef float f32x4 __attribute__((ext_vector_type(4)));
typedef unsigned u32x4 __attribute__((ext_vector_type(4)));
constexpr int BM = 256, BK = 64, HALF = 128, HTB = HALF * BK * 2  , STAGE_BYTES = 8 * HTB, NXCD = 8, WGM = 8;

__host__ __device__ __forceinline__ int lds_byte(int r, int c) { const int st = (r >> 4) * 2 + (c >> 5), rr = r & 15, cc = c & 31, ob = rr * 64 + cc * 2; return st * 1024 + (ob ^ (((ob >> 9) & 1) << 5)); }
__host__ __device__ __forceinline__ void stage_rc(int b, int& R, int& C) { const int st = b / 1024, sb = b % 1024, swz = sb ^ (((sb >> 9) & 1) << 5); R = (st >> 1) * 16 + swz / 64; C = (st & 1) * 32 + (swz % 64) / 2; }
__host__ __device__ __forceinline__ int perm32(int rho) { const int n = rho >> 4, i = rho & 15; return 8 * (i >> 2) + 4 * n + (i & 3); }

__device__ __forceinline__ int lane_id_fresh() { int l; asm volatile("v_mbcnt_lo_u32_b32 %0, -1, 0\n\tv_mbcnt_hi_u32_b32 %0, -1, %0" : "=v"(l)); return l; }
struct Unit { int pm, pn, k0t, nt; };
struct Gemm { const bf16_t* A; const bf16_t* Bt; int M, N, K, ld; };

struct StaticOrder {
    int nM, nN, nwg, G, c;
    __host__ __device__ __forceinline__ void init(int M, int N, int G_, int c_) { nM = M / BM; nN = N / BM; nwg = nM * nN; G = G_; c = c_; }
    __host__ __device__ __forceinline__ bool next(int i, Unit& u) const {
        const long L = (long)i * G + c; if (L >= nwg) return false;
        int wgid = (int)L; { const int q = nwg / NXCD, r = nwg % NXCD, xcd = wgid % NXCD, off = wgid / NXCD; wgid = (xcd < r ? xcd * (q + 1) : r * (q + 1) + (xcd - r) * q) + off; }
        const int nig = WGM * nN, gid = wgid / nig, fm = gid * WGM, gsz = (nM - fm) < WGM ? (nM - fm) : WGM;
        u.pm = fm + ((wgid % nig) % gsz); u.pn = (wgid % nig) / gsz; u.k0t = 0; u.nt = 0; return true;
    }
    __device__ __forceinline__ void a_ready(const Unit&) const {}
    __device__ __forceinline__ void done(const Unit&) const {}
};

__device__ __forceinline__ unsigned cvt_pk_bf16(float lo, float hi) { unsigned r; asm volatile("v_cvt_pk_bf16_f32 %0, %1, %2" : "=v"(r) : "v"(lo), "v"(hi)); return r; }
typedef float f32x2 __attribute__((ext_vector_type(2)));
__device__ __forceinline__ f32x2 gelu_pk(f32x2 v) {
    const f32x2 av = __builtin_elementwise_abs(v), d = av * 0.2316418882f + 1.0f;
    f32x2 t; t.x = __builtin_amdgcn_rcpf(d.x); t.y = __builtin_amdgcn_rcpf(d.y);
    f32x2 q = t * 0.5307027145f + (-0.7265760135f); q = q * t + 0.7107068705f; q = q * t + (-0.142248368f); q = q * t + 0.127414796f; q = q * t;
    const f32x2 s = (v * v) * (-0.72134752044f);
    f32x2 e; e.x = __builtin_amdgcn_exp2f(s.x); e.y = __builtin_amdgcn_exp2f(s.y);
    const f32x2 m = v * (q * e), r = v - m;
    f32x2 o; o.x = v.x < 0.f ? m.x : r.x; o.y = v.y < 0.f ? m.y : r.y; return o;
}

template <int ACT  > struct EpiBf16 {
    static constexpr bool PERM = true, AFTER_DRAIN = false; static_assert(ACT == 0 || ACT == 1, "EpiBf16: ACT is 0 (none) or 1 (gelu_pk)");
    bf16_t* O; int ldc; const float* bias; int split_cols; size_t split_stride; float scale0;
    __device__ __forceinline__ void operator()(const f32x4 (&acc)[2][2][4][2], const Unit& u, int wr, int wc, int fr, int fq) const {
        const int row0 = u.pm * BM + wr * 64 + fr; int colt = u.pn * BM; bf16_t* base = O;
        float sc = 1.f; if (split_cols) { const int t = colt / split_cols; base += (size_t)t * split_stride; colt -= t * split_cols; if (t == 0) sc = scale0; }
        const int col0 = colt + wc * 32 + 8 * fq, bcol0 = u.pn * BM + wc * 32 + 8 * fq;
        f32x4 bv[2][2];
#pragma unroll
        for (int bj = 0; bj < 2; ++bj)
#pragma unroll
            for (int n = 0; n < 2; ++n) bv[bj][n] = bias ? *(const f32x4*)(bias + bcol0 + bj * HALF + 4 * n) : (f32x4){0.f, 0.f, 0.f, 0.f};
#pragma unroll
        for (int ai = 0; ai < 2; ++ai)
#pragma unroll
            for (int m = 0; m < 4; ++m) { bf16_t* rowp = base + (size_t)(row0 + ai * HALF + m * 16) * ldc + col0;
#pragma unroll
                for (int bj = 0; bj < 2; ++bj) { f32x4 v0 = acc[ai][bj][m][0] + bv[bj][0], v1 = acc[ai][bj][m][1] + bv[bj][1];
                    if (ACT == 1) { f32x2 a = gelu_pk((f32x2){v0[0], v0[1]}), b = gelu_pk((f32x2){v0[2], v0[3]}), c = gelu_pk((f32x2){v1[0], v1[1]}), d = gelu_pk((f32x2){v1[2], v1[3]});
                        v0 = (f32x4){a.x, a.y, b.x, b.y}; v1 = (f32x4){c.x, c.y, d.x, d.y}; }
                    v0 = v0 * sc; v1 = v1 * sc; u32x4 w; w.x = cvt_pk_bf16(v0[0], v0[1]); w.y = cvt_pk_bf16(v0[2], v0[3]); w.z = cvt_pk_bf16(v1[0], v1[1]); w.w = cvt_pk_bf16(v1[2], v1[3]);
                    *(u32x4*)(rowp + bj * HALF) = w; } }
    }
};
template <class Epi, class Sched, bool ALIGN_EPI = false, bool SP2 = false>
__device__ __forceinline__ void gemm_phase(PG8_LAS unsigned char* lds, const Gemm g, const Sched& S, const Epi& E, const int wave_id) {
    int tid_ = wave_id * 64 + lane_id_fresh();
    const int tid = tid_, wid = __builtin_amdgcn_readfirstlane(tid >> 6), lane = tid & 63, wr = wid >> 2, wc = wid & 3, fr = lane & 15, fq = lane >> 4;
    const int K = g.ld, nt_full = g.K / BK;
    unsigned voffA[2], voffB[2];
#pragma unroll
    for (int i = 0; i < 2; ++i) { int R, C; stage_rc(tid * 16 + i * 8192, R, C); const int Rb = Epi::PERM ? ((R & ~31) + perm32(R & 31)) : R;
        voffA[i] = (unsigned)(R * K + C) * 2u; voffB[i] = (unsigned)(Rb * K + C) * 2u; }
    const size_t kstep = (size_t)(BK * 2);
    const size_t hstep = (size_t)HALF * K * 2;
    const size_t tstep = 2 * hstep;
    const unsigned ldsw = (unsigned)wid * 1024u;
    const int aoff = lds_byte(wr * 64 + fr, fq * 8), boff = lds_byte(wc * 32 + fr, fq * 8);
#define PG8_SA(b, h) (((b) * 2 + (h)) * HTB)
#define PG8_SB(b, h) ((4 + (b) * 2 + (h)) * HTB)
#define PG8_STAGE(bufoff, gbase, voff) do { _Pragma("unroll") for (int _i = 0; _i < 2; ++_i) \
        __builtin_amdgcn_global_load_lds((const unsigned*)((const char*)(gbase) + (voff)[_i]), (PG8_LAS unsigned*)(lds + (bufoff) + ldsw + _i * 8192), 16, 0, 0); } while (0)
#define PG8_LDA(dst, b, h) do { _Pragma("unroll") for (int m = 0; m < 4; ++m) _Pragma("unroll") for (int k = 0; k < 2; ++k) dst[m][k] = *(const PG8_LAS bf16x8*)(lds + PG8_SA(b, h) + aoff + m * 2048 + k * 1024); } while (0)
#define PG8_LDB(dst, b, h) do { _Pragma("unroll") for (int n = 0; n < 2; ++n) _Pragma("unroll") for (int k = 0; k < 2; ++k) dst[n][k] = *(const PG8_LAS bf16x8*)(lds + PG8_SB(b, h) + boff + n * 2048 + k * 1024); } while (0)
#define PG8_MMA(ai, bj, At, Bt) do { __builtin_amdgcn_s_setprio(1); _Pragma("unroll") for (int m = 0; m < 4; ++m) _Pragma("unroll") for (int n = 0; n < 2; ++n) _Pragma("unroll") for (int k = 0; k < 2; ++k) \
        acc[ai][bj][m][n] = __builtin_amdgcn_mfma_f32_16x16x32_bf16(Bt[n][k], At[m][k], acc[ai][bj][m][n], 0, 0, 0); __builtin_amdgcn_s_setprio(0); } while (0)
#define PG8_WAIT_V(n) asm volatile("s_waitcnt vmcnt(" #n ")" ::: "memory")
#define PG8_WAIT_L(n) asm volatile("s_waitcnt lgkmcnt(" #n ")" ::: "memory")
#define PG8_BAR __builtin_amdgcn_s_barrier()
#define PG8_SCHED __builtin_amdgcn_sched_barrier(0)
    Unit cur, nxt; int ui = 0;
    if (!S.next(0, cur)) return;
    f32x4 acc[2][2][4][2];
#pragma unroll
    for (int a = 0; a < 2; ++a)
#pragma unroll
        for (int b = 0; b < 2; ++b)
#pragma unroll
            for (int m = 0; m < 4; ++m)
#pragma unroll
                for (int n = 0; n < 2; ++n) acc[a][b][m][n] = (f32x4){0.f, 0.f, 0.f, 0.f};
    bf16x8 At[4][2], B0[2][2], B1[2][2];
    const char* cA = (const char*)g.A + (size_t)cur.pm * tstep + (size_t)cur.k0t * kstep; const char* cB = (const char*)g.Bt + (size_t)cur.pn * tstep + (size_t)cur.k0t * kstep;
    int nt = cur.nt ? cur.nt : nt_full;
    S.a_ready(cur);
    if constexpr (SP2) {
        PG8_STAGE(PG8_SB(0, 0), cB, voffB); PG8_STAGE(PG8_SB(0, 1), cB + hstep, voffB); PG8_STAGE(PG8_SA(0, 0), cA, voffA); PG8_STAGE(PG8_SA(0, 1), cA + hstep, voffA);
        if (wr == 1) PG8_BAR;
        PG8_WAIT_V(2); PG8_BAR;
        PG8_STAGE(PG8_SB(1, 0), cB + kstep, voffB); PG8_STAGE(PG8_SA(1, 0), cA + kstep, voffA); PG8_STAGE(PG8_SB(1, 1), cB + hstep + kstep, voffB);
        PG8_WAIT_V(6); PG8_BAR;
    } else {
        PG8_STAGE(PG8_SB(0, 0), cB, voffB); PG8_STAGE(PG8_SA(0, 0), cA, voffA); PG8_STAGE(PG8_SB(0, 1), cB + hstep, voffB); PG8_STAGE(PG8_SA(0, 1), cA + hstep, voffA);
        if (wr == 1) PG8_BAR;
        PG8_WAIT_V(4); PG8_BAR;
        PG8_STAGE(PG8_SB(1, 0), cB + kstep, voffB); PG8_STAGE(PG8_SA(1, 0), cA + kstep, voffA); PG8_STAGE(PG8_SB(1, 1), cB + hstep + kstep, voffB);
        PG8_WAIT_V(6); PG8_BAR;
    }
    for (;;) {
        const bool has_next = S.next(ui + 1, nxt);
        const char* nA = has_next ? (const char*)g.A + (size_t)nxt.pm * tstep + (size_t)nxt.k0t * kstep : cA; const char* nB = has_next ? (const char*)g.Bt + (size_t)nxt.pn * tstep + (size_t)nxt.k0t * kstep : cB;
        for (int t = 0; t < nt; t += 2) {
            const bool last = (t == nt - 2);
            const char* a1 = cA + (size_t)(t + 1) * kstep;
            const char* a2 = last ? nA : cA + (size_t)(t + 2) * kstep; const char* b2 = last ? nB : cB + (size_t)(t + 2) * kstep;
            const char* a3 = a2 + kstep; const char* b3 = b2 + kstep;
            if (last && has_next) S.a_ready(nxt);
            if constexpr (SP2) {
            PG8_LDB(B0, 0, 0); PG8_LDB(B1, 0, 1); PG8_SCHED; PG8_LDA(At, 0, 0); PG8_STAGE(PG8_SA(1, 1), a1 + hstep, voffA);
            PG8_WAIT_V(8); PG8_WAIT_L(0); PG8_BAR; PG8_MMA(0, 0, At, B0); PG8_MMA(0, 1, At, B1); PG8_BAR; PG8_SCHED;
            PG8_LDA(At, 0, 1); PG8_STAGE(PG8_SB(0, 0), b2, voffB); PG8_STAGE(PG8_SB(0, 1), b2 + hstep, voffB); PG8_STAGE(PG8_SA(0, 0), a2, voffA);
            PG8_WAIT_V(8); PG8_WAIT_L(0); PG8_BAR; PG8_MMA(1, 0, At, B0); PG8_MMA(1, 1, At, B1); PG8_BAR; PG8_SCHED;
            PG8_LDB(B0, 1, 0); PG8_LDB(B1, 1, 1); PG8_SCHED; PG8_LDA(At, 1, 0); PG8_STAGE(PG8_SA(0, 1), a2 + hstep, voffA);
            PG8_WAIT_V(8); PG8_WAIT_L(0); PG8_BAR; PG8_MMA(0, 0, At, B0); PG8_MMA(0, 1, At, B1); PG8_BAR; PG8_SCHED;
            PG8_LDA(At, 1, 1); PG8_STAGE(PG8_SB(1, 0), b3, voffB); PG8_STAGE(PG8_SB(1, 1), b3 + hstep, voffB); PG8_STAGE(PG8_SA(1, 0), a3, voffA);
            PG8_WAIT_V(8); PG8_WAIT_L(0); PG8_BAR; PG8_MMA(1, 0, At, B0); PG8_MMA(1, 1, At, B1); PG8_BAR; PG8_SCHED;
            } else {
            PG8_LDB(B0, 0, 0); PG8_SCHED; PG8_LDA(At, 0, 0); PG8_STAGE(PG8_SA(1, 1), a1 + hstep, voffA);
            PG8_WAIT_L(8); PG8_BAR; PG8_WAIT_L(0); PG8_MMA(0, 0, At, B0); PG8_BAR; PG8_SCHED;
            PG8_LDB(B1, 0, 1); PG8_STAGE(PG8_SB(0, 0), b2, voffB);
            PG8_BAR; PG8_WAIT_L(0); PG8_MMA(0, 1, At, B1); PG8_BAR;
            PG8_LDA(At, 0, 1); PG8_STAGE(PG8_SA(0, 0), a2, voffA);
            PG8_BAR; PG8_WAIT_L(0); PG8_MMA(1, 0, At, B0); PG8_BAR; PG8_SCHED;
            PG8_STAGE(PG8_SB(0, 1), b2 + hstep, voffB);
            PG8_WAIT_V(6); PG8_BAR; PG8_MMA(1, 1, At, B1); PG8_BAR;
            PG8_LDB(B0, 1, 0); PG8_SCHED; PG8_LDA(At, 1, 0); PG8_STAGE(PG8_SA(0, 1), a2 + hstep, voffA);
            PG8_WAIT_L(8); PG8_BAR; PG8_WAIT_L(0); PG8_MMA(0, 0, At, B0); PG8_BAR; PG8_SCHED;
            PG8_LDB(B1, 1, 1); PG8_STAGE(PG8_SB(1, 0), b3, voffB);
            PG8_BAR; PG8_WAIT_L(0); PG8_MMA(0, 1, At, B1); PG8_BAR;
            PG8_LDA(At, 1, 1); PG8_STAGE(PG8_SA(1, 0), a3, voffA);
            PG8_BAR; PG8_WAIT_L(0); PG8_MMA(1, 0, At, B0); PG8_BAR; PG8_SCHED;
            PG8_STAGE(PG8_SB(1, 1), b3 + hstep, voffB);
            PG8_WAIT_V(6); PG8_BAR; PG8_MMA(1, 1, At, B1); PG8_BAR;
            }
        }
        if constexpr (ALIGN_EPI) { if (wr == 0) PG8_BAR; }
        if constexpr (!Epi::AFTER_DRAIN) { E(acc, cur, wr, wc, fr, fq); S.done(cur); }
        if (!has_next) break;
#pragma unroll
        for (int a = 0; a < 2; ++a)
#pragma unroll
            for (int b = 0; b < 2; ++b)
#pragma unroll
                for (int m = 0; m < 4; ++m)
#pragma unroll
                    for (int n = 0; n < 2; ++n) acc[a][b][m][n] = (f32x4){0.f, 0.f, 0.f, 0.f};
        cur = nxt; cA = nA; cB = nB; ++ui; nt = cur.nt ? cur.nt : nt_full;
        if constexpr (ALIGN_EPI) { if (wr == 1) PG8_BAR; }
    }
    PG8_WAIT_V(0);
    if constexpr (!ALIGN_EPI) { if (wr == 0) PG8_BAR; }
    PG8_BAR;
    if constexpr (Epi::AFTER_DRAIN) { E.fused(acc, cur, wr, wc, fr, fq, lds, wid, lane); S.done(cur); }
#undef PG8_SA
#undef PG8_SB
#undef PG8_STAGE
#undef PG8_LDA
#undef PG8_LDB
#undef PG8_MMA
#undef PG8_WAIT_V
#undef PG8_WAIT_L
#undef PG8_BAR
#undef PG8_SCHED
}
}

#define GAS __attribute__((address_space(1)))
#define LAS __attribute__((address_space(3)))
typedef unsigned short bf16;
typedef unsigned v4u __attribute__((ext_vector_type(4)));
typedef unsigned v2u __attribute__((ext_vector_type(2)));
typedef float f32x4 __attribute__((ext_vector_type(4)));
typedef float f32x2 __attribute__((ext_vector_type(2)));
typedef float f32x16 __attribute__((ext_vector_type(16)));
typedef short bf16x8 __attribute__((ext_vector_type(8)));
typedef short s16x4 __attribute__((ext_vector_type(4)));
typedef __bf16 bf16x2_t __attribute__((ext_vector_type(2)));
#define MFMA32(a, b, c) __builtin_amdgcn_mfma_f32_32x32x16_bf16((a), (b), (c), 0, 0, 0)

constexpr int NWAVES = 8, NTHR = 512;
constexpr int MP = 16384, MS = 2048, M = MP + MS, D = 1024, NPROJ = 1280, DFF = 2816, SSMW = 512;
constexpr float LN_EPS = 1e-5f, DN_ALPHA = 1.189207115002721f;
constexpr size_t O_Y = 0, O_WKP = 18874368, O_WVP = 18939904, O_SRP = 19005440, O_SIP = 19013632, O_WKS = 19021824, O_WVS = 19546112, O_SRS = 20070400, O_SIS = 20135936;
constexpr size_t MiB = 1u << 20;
constexpr size_t WS_WIN = 1 * MiB, WS_WGLU = 4 * MiB, WS_WOUT = 5 * MiB, WS_WGU = 7 * MiB, WS_WDN = 18 * MiB;
constexpr size_t WS_W1T = 24 * MiB, WS_TZT = 26 * MiB, WS_W3P = 30 * MiB, WS_POW16 = 32 * MiB, WS_POWL = 32 * MiB + 640 * 1024, WS_E = 33 * MiB, WS_BBAR = 33 * MiB + 512 * 1024;
constexpr size_t WS_KBS = 38 * MiB, WS_VTS = 39 * MiB + 512 * 1024;
constexpr size_t WS_PRE = 214 * MiB;
constexpr size_t WS_PART1 = 114 * MiB, WS_PART2 = 78 * MiB;
constexpr size_t WS_QF = 114 * MiB, WS_UF = 132 * MiB, WS_KFP = 150 * MiB, WS_VFP = 154 * MiB;
constexpr size_t WS_H = 42 * MiB, WS_X0 = 78 * MiB, WS_PROJ = 114 * MiB, WS_MIX = 159 * MiB, WS_YS = 195 * MiB, WS_ACT = 114 * MiB, WS_END = 246 * MiB;
static_assert(WS_POW16 + 2048 * 33 * 8 <= WS_POWL && WS_POWL + 2048 * 17 * 8 <= WS_E && WS_E + 4 * 8 * 32 * 128 * 4 <= WS_BBAR && WS_BBAR + 32 * 64 * 16 * 8 <= WS_KBS, "ws map");
static_assert(WS_ACT + (size_t)M * DFF * 2 <= WS_END && WS_YS + (size_t)M * SSMW * 2 <= WS_END && WS_VFP + 4 * MiB <= WS_MIX && WS_MIX + (size_t)M * D * 2 <= WS_YS, "ws map 2");
constexpr int LDS_BYTES = 150528;

__device__ __forceinline__ unsigned pk2(float lo, float hi) { f32x2 v = {lo, hi}; bf16x2_t b = __builtin_convertvector(v, bf16x2_t); return __builtin_bit_cast(unsigned, b); }
__device__ __forceinline__ bf16 f2bf(float f) { return (bf16)(pk2(f, 0.f) & 0xffffu); }
__device__ __forceinline__ float bflo(unsigned w) { return __uint_as_float(w << 16); }
__device__ __forceinline__ float bfhi(unsigned w) { return __uint_as_float(w & 0xffff0000u); }
__device__ __forceinline__ float sigmoidf_(float x) { return __builtin_amdgcn_rcpf(1.0f + __builtin_amdgcn_exp2f(x * -1.44269504089f)); }
__device__ __forceinline__ unsigned swiglu_pk(float g0, float g1, float u0, float u1) {
    const f32x2 g = {g0, g1}, u = {u0, u1}; const f32x2 t = g * -1.44269504089f;
    f32x2 e; e.x = __builtin_amdgcn_exp2f(t.x); e.y = __builtin_amdgcn_exp2f(t.y);
    const f32x2 d = e + 1.0f; f32x2 r; r.x = __builtin_amdgcn_rcpf(d.x); r.y = __builtin_amdgcn_rcpf(d.y);
    const f32x2 o = (g * u) * r; return pk2(o.x, o.y);
}
__device__ __forceinline__ float wave_sum(float v) {
#pragma unroll
    for (int o = 1; o < 64; o <<= 1) v += __shfl_xor(v, o);
    return v;
}

struct Args { const float* in[27]; float* out; unsigned char* ws; };
enum { I_XP = 0, I_XS, I_CK, I_CV, I_SRE, I_SIM, I_LNG, I_LNB, I_WIN, I_SINK, I_LRE, I_LIM, I_LSTEP, I_BRE, I_BIM, I_CRE, I_CIM, I_DSK, I_WGLU, I_BGLU, I_WOUT, I_L1G, I_L1B, I_WGU, I_WDN, I_L2G, I_L2B };

using pg8::Unit; using pg8::HALF;
__device__ __forceinline__ int vf_off(int key, int d) {
    const int w = key & 31; return (((w >> 4) * 2 + (d >> 5)) * 64 + ((w >> 2) & 1) * 32 + (d & 31)) * 8 + 4 * ((w >> 3) & 1) + (w & 3);
}
struct EpiProj {
    static constexpr bool PERM = true, AFTER_DRAIN = false;
    bf16* QF; bf16* UF; bf16* KFp; bf16* VFp; bf16* KFs; bf16* VFs; float* out;
    __device__ __forceinline__ void operator()(const pg8::f32x4 (&acc)[2][2][4][2], const Unit& u, int wr, int wc, int fr, int fq) const {
        const int row0 = u.pm * 256 + wr * 64 + fr, colb = u.pn * 256 + wc * 32 + 8 * fq;
        if (u.pn != 2) {
#pragma unroll
            for (int ai = 0; ai < 2; ++ai)
#pragma unroll
                for (int m = 0; m < 4; ++m) { const int row = row0 + ai * HALF + m * 16;
#pragma unroll
                    for (int bj = 0; bj < 2; ++bj) { const pg8::f32x4 v0 = acc[ai][bj][m][0], v1 = acc[ai][bj][m][1]; const int col = colb + bj * HALF;
                        v4u w; w.x = pk2(v0[0], v0[1]); w.y = pk2(v0[2], v0[3]); w.z = pk2(v1[0], v1[1]); w.w = pk2(v1[2], v1[3]);
                        if (u.pn < 2) { const int head = col >> 6, d0 = col & 63;
                            *(v4u*)(QF + ((size_t)(((row >> 5) * 8 + head) * 4 + (d0 >> 4)) * 64 + ((d0 >> 3) & 1) * 32 + (row & 31)) * 8) = w; }
                        else { const int c8 = col - 768, g = c8 >> 4;
                            *(v4u*)(UF + ((size_t)(((row >> 9) * 32 + g) * 16 + (row & 15)) * 64 + ((c8 >> 3) & 1) * 32 + ((row & 511) >> 4)) * 8) = w; } } }
        } else {
            const int colk = wc * 32 + 8 * fq, kvh = colk >> 6, d0 = colk & 63;
#pragma unroll
            for (int ai = 0; ai < 2; ++ai)
#pragma unroll
                for (int m = 0; m < 4; ++m) { const int row = row0 + ai * HALF + m * 16;
                    int b, key, nb; bf16 *kf, *vf; float *ok, *ov; bool wout;
                    if (u.pm < 64) { b = row >> 12; key = row & 4095; nb = 128; kf = KFp; vf = VFp; wout = key >= 3968;
                        ok = out + O_WKP + (size_t)(b * 128 + (key - 3968)) * 128 + colk; ov = out + O_WVP + (size_t)(b * 128 + (key - 3968)) * 128 + colk; }
                    else { const int srow = row - MP; b = srow >> 6; const int t = srow & 63; key = 128 + t; nb = 6; kf = KFs; vf = VFs; wout = true;
                        ok = out + O_WKS + (size_t)(b * 128 + 64 + t) * 128 + colk; ov = out + O_WVS + (size_t)(b * 128 + 64 + t) * 128 + colk; }
                    const size_t blk = (size_t)((b * 2 + kvh) * nb + (key >> 5));
                    const pg8::f32x4 k0 = acc[ai][0][m][0], k1 = acc[ai][0][m][1];
                    v4u w; w.x = pk2(k0[0], k0[1]); w.y = pk2(k0[2], k0[3]); w.z = pk2(k1[0], k1[1]); w.w = pk2(k1[2], k1[3]);
                    *(v4u*)(kf + ((blk * 4 + (d0 >> 4)) * 64 + ((d0 >> 3) & 1) * 32 + (key & 31)) * 8) = w;
#pragma unroll
                    for (int n = 0; n < 2; ++n)
#pragma unroll
                        for (int e = 0; e < 4; ++e) vf[blk * 2048 + vf_off(key, d0 + 4 * n + e)] = f2bf(acc[ai][1][m][n][e]);
                    if (wout) {
#pragma unroll
                        for (int n = 0; n < 2; ++n) { *(pg8::f32x4*)(ok + 4 * n) = acc[ai][0][m][n]; *(pg8::f32x4*)(ov + 4 * n) = acc[ai][1][m][n]; } }
                }
        }
    }
};
struct EpiGlu {
    static constexpr bool PERM = true, AFTER_DRAIN = false;
    const bf16* YS; bf16* MIX; const float* bglu;
    __device__ __forceinline__ void operator()(const pg8::f32x4 (&acc)[2][2][4][2], const Unit& u, int wr, int wc, int fr, int fq) const {
        const int row0 = u.pm * 256 + wr * 64 + fr, colb = u.pn * 256 + wc * 32 + 8 * fq;
#pragma unroll
        for (int bj = 0; bj < 2; ++bj) { const int col = colb + bj * HALF;
            const pg8::f32x4 b0 = *(const pg8::f32x4*)(bglu + col), b1 = *(const pg8::f32x4*)(bglu + col + 4);
#pragma unroll
            for (int ai = 0; ai < 2; ++ai)
#pragma unroll
                for (int m = 0; m < 4; ++m) { const int row = row0 + ai * HALF + m * 16;
                    const v4u y = *(const v4u*)(YS + (size_t)row * SSMW + col);
                    const pg8::f32x4 v0 = acc[ai][bj][m][0] + b0, v1 = acc[ai][bj][m][1] + b1;
                    v4u w;
                    w.x = pk2(bflo(y.x) * sigmoidf_(v0[0]), bfhi(y.x) * sigmoidf_(v0[1])); w.y = pk2(bflo(y.y) * sigmoidf_(v0[2]), bfhi(y.y) * sigmoidf_(v0[3]));
                    w.z = pk2(bflo(y.z) * sigmoidf_(v1[0]), bfhi(y.z) * sigmoidf_(v1[1])); w.w = pk2(bflo(y.w) * sigmoidf_(v1[2]), bfhi(y.w) * sigmoidf_(v1[3]));
                    *(v4u*)(MIX + (size_t)row * D + 512 + col) = w; } }
    }
};
struct EpiRes {
    static constexpr bool PERM = false, AFTER_DRAIN = false;
    const bf16* R; float* out;
    __device__ __forceinline__ void operator()(const pg8::f32x4 (&acc)[2][2][4][2], const Unit& u, int wr, int wc, int fr, int fq) const {
        const int row0 = u.pm * 256 + wr * 64 + fr, colb = u.pn * 256 + wc * 32 + 4 * fq;
#pragma unroll
        for (int ai = 0; ai < 2; ++ai)
#pragma unroll
            for (int m = 0; m < 4; ++m) { const size_t off = (size_t)(row0 + ai * HALF + m * 16) * D + colb;
#pragma unroll
                for (int bj = 0; bj < 2; ++bj)
#pragma unroll
                    for (int n = 0; n < 2; ++n) { const v2u r = *(const v2u*)(R + off + bj * HALF + n * 16);
                        pg8::f32x4 o = acc[ai][bj][m][n];
                        o[0] += DN_ALPHA * bflo(r.x); o[1] += DN_ALPHA * bfhi(r.x); o[2] += DN_ALPHA * bflo(r.y); o[3] += DN_ALPHA * bfhi(r.y);
                        *(pg8::f32x4*)(out + off + bj * HALF + n * 16) = o; } }
    }
};
struct EpiSwiglu {
    static constexpr bool PERM = true, AFTER_DRAIN = false;
    bf16* ACT;
    __device__ __forceinline__ void operator()(const pg8::f32x4 (&acc)[2][2][4][2], const Unit& u, int wr, int wc, int fr, int fq) const {
        const int row0 = u.pm * 256 + wr * 64 + fr, col = u.pn * 128 + wc * 32 + 8 * fq;
#pragma unroll
        for (int ai = 0; ai < 2; ++ai)
#pragma unroll
            for (int m = 0; m < 4; ++m) { const int row = row0 + ai * HALF + m * 16;
                const pg8::f32x4 g0 = acc[ai][0][m][0], g1 = acc[ai][0][m][1], u0 = acc[ai][1][m][0], u1 = acc[ai][1][m][1];
                v4u w;
                w.x = swiglu_pk(g0[0], g0[1], u0[0], u0[1]); w.y = swiglu_pk(g0[2], g0[3], u0[2], u0[3]);
                w.z = swiglu_pk(g1[0], g1[1], u1[0], u1[1]); w.w = swiglu_pk(g1[2], g1[3], u1[2], u1[3]);
                *(v4u*)(ACT + (size_t)row * DFF + col) = w; }
    }
};

struct MainTail {
    pg8::StaticOrder S; int nmain, tpm, tpn, k0t, nt; bool has_tail;
    __device__ __forceinline__ void init(int G, int c, int nt_full, int split_nt0, int split_nt1) {
        S.init(MP, D, G, c); nmain = (S.nwg - c + G - 1) / G; if (nmain < 0) nmain = 0;
        has_tail = c < 128 && G >= 128; tpm = 64 + (c >> 4); tpn = (c >> 2) & 3; const int sp = c & 3;
        k0t = sp < 2 ? sp * split_nt0 : 2 * split_nt0 + (sp - 2) * split_nt1; nt = sp < 2 ? split_nt0 : split_nt1; (void)nt_full;
    }
    __device__ __forceinline__ bool next(int i, Unit& u) const { if (i < nmain) return S.next(i, u); if (i == nmain && has_tail) { u.pm = tpm; u.pn = tpn; u.k0t = k0t; u.nt = nt; return true; } return false; }
    __device__ __forceinline__ void a_ready(const Unit&) const {}
    __device__ __forceinline__ void done(const Unit&) const {}
};
struct EpiResTail {
    static constexpr bool PERM = true, AFTER_DRAIN = false;
    const bf16* R; bf16* out; bf16* P;
    __device__ __forceinline__ void operator()(const pg8::f32x4 (&acc)[2][2][4][2], const Unit& u, int wr, int wc, int fr, int fq) const {
        const int colb = u.pn * 256 + wc * 32 + 8 * fq;
        if (u.pm < 64) { const int row0 = u.pm * 256 + wr * 64 + fr;
#pragma unroll
            for (int ai = 0; ai < 2; ++ai)
#pragma unroll
                for (int m = 0; m < 4; ++m) { const size_t off = (size_t)(row0 + ai * HALF + m * 16) * D + colb;
#pragma unroll
                    for (int bj = 0; bj < 2; ++bj) { const v4u r = *(const v4u*)(R + off + bj * HALF);
                        const pg8::f32x4 a0 = acc[ai][bj][m][0], a1 = acc[ai][bj][m][1];
                        v4u w; w.x = pk2(a0[0] + DN_ALPHA * bflo(r.x), a0[1] + DN_ALPHA * bfhi(r.x)); w.y = pk2(a0[2] + DN_ALPHA * bflo(r.y), a0[3] + DN_ALPHA * bfhi(r.y));
                        w.z = pk2(a1[0] + DN_ALPHA * bflo(r.z), a1[1] + DN_ALPHA * bfhi(r.z)); w.w = pk2(a1[2] + DN_ALPHA * bflo(r.w), a1[3] + DN_ALPHA * bfhi(r.w));
                        *(v4u*)(out + off + bj * HALF) = w; } }
        } else { const int row0 = (u.pm - 64) * 256 + wr * 64 + fr;
#pragma unroll
            for (int ai = 0; ai < 2; ++ai)
#pragma unroll
                for (int m = 0; m < 4; ++m) { const size_t off = (size_t)(row0 + ai * HALF + m * 16) * D + colb;
#pragma unroll
                    for (int bj = 0; bj < 2; ++bj) { const pg8::f32x4 a0 = acc[ai][bj][m][0], a1 = acc[ai][bj][m][1];
                        v4u w; w.x = pk2(a0[0], a0[1]); w.y = pk2(a0[2], a0[3]); w.z = pk2(a1[0], a1[1]); w.w = pk2(a1[2], a1[3]);
                        *(v4u*)(P + off + bj * HALF) = w; } }
        }
    }
};

struct Frame {
    LAS unsigned char* lds; int tid, lane, wave, G, gw, NGW, gt, NGT;
    const float* in[27]; float* out; unsigned char* ws;
};

__device__ __forceinline__ void transpose_item(const float* W, int K, int N, bf16* WT, int k0, int sc0, int dr0, LAS float* scr, int lane) {
    float tv[32];
#pragma unroll
    for (int i = 0; i < 32; ++i) tv[i] = W[(size_t)(k0 + 2 * i + (lane >> 5)) * N + sc0 + (lane & 31)];
#pragma unroll
    for (int i = 0; i < 32; ++i) scr[(2 * i + (lane >> 5)) * 33 + (lane & 31)] = tv[i];
    asm volatile("s_waitcnt lgkmcnt(0)" ::: "memory");
    const int c = lane & 7;
#pragma unroll
    for (int j = 0; j < 4; ++j) { const int n = (lane >> 3) + 8 * j; const LAS float* s = scr + (8 * c) * 33 + n;
        v4u o; o.x = pk2(s[0 * 33], s[1 * 33]); o.y = pk2(s[2 * 33], s[3 * 33]); o.z = pk2(s[4 * 33], s[5 * 33]); o.w = pk2(s[6 * 33], s[7 * 33]);
        *(v4u*)(WT + (size_t)(dr0 + n) * K + k0 + 8 * c) = o; }
    asm volatile("s_waitcnt lgkmcnt(0)" ::: "memory");
}
template <bool TO_BF16>
__device__ __forceinline__ void ln_row(const float* xrow, const float* g, const float* b, void* orow, int lane, const bf16* part = nullptr, const bf16* resid = nullptr) {
    const f32x4* xr = (const f32x4*)xrow + lane;
    f32x4 v[4]; float s = 0.f;
    if (part) {
#pragma unroll
        for (int j = 0; j < 4; ++j) { const v2u* pr = (const v2u*)part + lane + 64 * j; const size_t ps = (size_t)MS * D / 4;
            const v2u rr = ((const v2u*)resid)[lane + 64 * j];
            const v2u p0 = pr[0], p1 = pr[ps], p2 = pr[2 * ps], p3 = pr[3 * ps];
            v[j] = (f32x4){(bflo(p0.x) + bflo(p1.x)) + (bflo(p2.x) + bflo(p3.x)), (bfhi(p0.x) + bfhi(p1.x)) + (bfhi(p2.x) + bfhi(p3.x)),
                           (bflo(p0.y) + bflo(p1.y)) + (bflo(p2.y) + bflo(p3.y)), (bfhi(p0.y) + bfhi(p1.y)) + (bfhi(p2.y) + bfhi(p3.y))};
            v[j].x += DN_ALPHA * bflo(rr.x); v[j].y += DN_ALPHA * bfhi(rr.x); v[j].z += DN_ALPHA * bflo(rr.y); v[j].w += DN_ALPHA * bfhi(rr.y);
            s += (v[j].x + v[j].y) + (v[j].z + v[j].w); }
    } else {
#pragma unroll
    for (int j = 0; j < 4; ++j) { v[j] = xr[64 * j]; s += (v[j].x + v[j].y) + (v[j].z + v[j].w); }
    }
    const float mean = wave_sum(s) * (1.f / D); float s2 = 0.f;
#pragma unroll
    for (int j = 0; j < 4; ++j) { v[j] = v[j] - mean; s2 += (v[j].x * v[j].x + v[j].y * v[j].y) + (v[j].z * v[j].z + v[j].w * v[j].w); }
    const float rstd = 1.f / sqrtf(wave_sum(s2) * (1.f / D) + LN_EPS);
#pragma unroll
    for (int j = 0; j < 4; ++j) { const f32x4 gg = ((const f32x4*)g)[lane + 64 * j], bb = ((const f32x4*)b)[lane + 64 * j];
        const f32x4 o = v[j] * rstd * gg + bb;
        if (TO_BF16) { v2u w; w.x = pk2(o.x, o.y); w.y = pk2(o.z, o.w); ((v2u*)orow)[lane + 64 * j] = w; }
        else ((f32x4*)orow)[lane + 64 * j] = o; }
}

template <bool TO_BF16, bool IN_BF16 = false>
__device__ __forceinline__ void ln_rows4(const void* xrow_, size_t xstride, const float* g, const float* b, void* orow, size_t ostride, int lane) {
    f32x4 v[4][4]; float s[4], s2[4];
#pragma unroll
    for (int i = 0; i < 4; ++i)
#pragma unroll
        for (int j = 0; j < 4; ++j) {
            if (IN_BF16) { const v2u w = ((const v2u*)((const bf16*)xrow_ + i * xstride))[lane + 64 * j]; v[i][j] = (f32x4){bflo(w.x), bfhi(w.x), bflo(w.y), bfhi(w.y)}; }
            else v[i][j] = __builtin_nontemporal_load((const f32x4*)((const float*)xrow_ + i * xstride) + lane + 64 * j); }
#pragma unroll
    for (int i = 0; i < 4; ++i) { s[i] = 0.f;
#pragma unroll
        for (int j = 0; j < 4; ++j) s[i] += (v[i][j].x + v[i][j].y) + (v[i][j].z + v[i][j].w); }
#pragma unroll
    for (int o = 1; o < 64; o <<= 1) {
#pragma unroll
        for (int i = 0; i < 4; ++i) s[i] += __shfl_xor(s[i], o); }
#pragma unroll
    for (int i = 0; i < 4; ++i) { const float mean = s[i] * (1.f / D); s2[i] = 0.f;
#pragma unroll
        for (int j = 0; j < 4; ++j) { v[i][j] = v[i][j] - mean; s2[i] += (v[i][j].x * v[i][j].x + v[i][j].y * v[i][j].y) + (v[i][j].z * v[i][j].z + v[i][j].w * v[i][j].w); } }
#pragma unroll
    for (int o = 1; o < 64; o <<= 1) {
#pragma unroll
        for (int i = 0; i < 4; ++i) s2[i] += __shfl_xor(s2[i], o); }
#pragma unroll
    for (int j = 0; j < 4; ++j) { const f32x4 gg = ((const f32x4*)g)[lane + 64 * j], bb = ((const f32x4*)b)[lane + 64 * j];
#pragma unroll
        for (int i = 0; i < 4; ++i) { const float rstd = 1.f / sqrtf(s2[i] * (1.f / D) + LN_EPS); const f32x4 o = v[i][j] * rstd * gg + bb;
            if (TO_BF16) { v2u w; w.x = pk2(o.x, o.y); w.y = pk2(o.z, o.w); ((v2u*)((bf16*)orow + i * ostride))[lane + 64 * j] = w; }
            else __builtin_nontemporal_store(o, (f32x4*)((float*)orow + i * ostride) + lane + 64 * j); } }
}
__device__ __forceinline__ void ln_rows4_b16(const bf16* xrow, const float* g, const float* b, bf16* orow, int lane) {
    f32x4 v[4][2][2]; float s[4], s2[4];
#pragma unroll
    for (int i = 0; i < 4; ++i)
#pragma unroll
        for (int j = 0; j < 2; ++j) { const v4u w = ((const v4u*)(xrow + (size_t)i * D))[lane + 64 * j];
            v[i][j][0] = (f32x4){bflo(w.x), bfhi(w.x), bflo(w.y), bfhi(w.y)}; v[i][j][1] = (f32x4){bflo(w.z), bfhi(w.z), bflo(w.w), bfhi(w.w)}; }
#pragma unroll
    for (int i = 0; i < 4; ++i) { s[i] = 0.f;
#pragma unroll
        for (int j = 0; j < 2; ++j)
#pragma unroll
            for (int k = 0; k < 2; ++k) s[i] += (v[i][j][k].x + v[i][j][k].y) + (v[i][j][k].z + v[i][j][k].w); }
#pragma unroll
    for (int o = 1; o < 64; o <<= 1) {
#pragma unroll
        for (int i = 0; i < 4; ++i) s[i] += __shfl_xor(s[i], o); }
#pragma unroll
    for (int i = 0; i < 4; ++i) { const float mean = s[i] * (1.f / D); s2[i] = 0.f;
#pragma unroll
        for (int j = 0; j < 2; ++j)
#pragma unroll
            for (int k = 0; k < 2; ++k) { v[i][j][k] = v[i][j][k] - mean; s2[i] += (v[i][j][k].x * v[i][j][k].x + v[i][j][k].y * v[i][j][k].y) + (v[i][j][k].z * v[i][j][k].z + v[i][j][k].w * v[i][j][k].w); } }
#pragma unroll
    for (int o = 1; o < 64; o <<= 1) {
#pragma unroll
        for (int i = 0; i < 4; ++i) s2[i] += __shfl_xor(s2[i], o); }
#pragma unroll
    for (int j = 0; j < 2; ++j) { const f32x4 g0 = ((const f32x4*)g)[2 * (lane + 64 * j)], g1 = ((const f32x4*)g)[2 * (lane + 64 * j) + 1], b0 = ((const f32x4*)b)[2 * (lane + 64 * j)], b1 = ((const f32x4*)b)[2 * (lane + 64 * j) + 1];
#pragma unroll
        for (int i = 0; i < 4; ++i) { const float rstd = 1.f / sqrtf(s2[i] * (1.f / D) + LN_EPS); const f32x4 o0 = v[i][j][0] * rstd * g0 + b0, o1 = v[i][j][1] * rstd * g1 + b1;
            v4u w; w.x = pk2(o0.x, o0.y); w.y = pk2(o0.z, o0.w); w.z = pk2(o1.x, o1.y); w.w = pk2(o1.z, o1.w);
            ((v4u*)(orow + (size_t)i * D))[lane + 64 * j] = w; } }
}
__device__ __forceinline__ void ssm_polar(const float* const (&in)[27], int g, int p, float k, float& re, float& im) {
    const float dt = expf(in[I_LSTEP][g]); const float lr = in[I_LRE][g * 64 + p], li = in[I_LIM][g * 64 + p];
    const float mag = expf(lr * dt * k);
    double ang = (double)li * (double)dt * (double)k; ang -= 6.283185307179586476925 * rint(ang * 0.15915494309189533577);
    const float a = (float)ang; re = mag * cosf(a); im = mag * sinf(a);
}

__device__ __forceinline__ void p2_ffn_weights(Frame& F, int wi, int nw) {
    LAS float* scr = (LAS float*)(F.lds + F.wave * 16384);
    constexpr int I_GU = 16 * 176, I_DN = 44 * 32;
    for (int it = wi; it < I_GU + I_DN; it += nw) {
        if (it < I_GU) { const int kb = it / 176, nb = it % 176, dr0 = 32 * nb, tile = dr0 >> 8, within = dr0 & 255;
            const int sc0 = within < 128 ? tile * 128 + within : DFF + tile * 128 + within - 128;
            transpose_item(F.in[I_WGU], D, 2 * DFF, (bf16*)(F.ws + WS_WGU), 64 * kb, sc0, dr0, scr, F.lane); }
        else { const int r = it - I_GU, kb = r / 32, nb = r % 32; transpose_item(F.in[I_WDN], DFF, D, (bf16*)(F.ws + WS_WDN), 64 * kb, 32 * nb, 32 * nb, scr, F.lane); }
    }
}
__device__ __forceinline__ void p0a_small(Frame& F) {
    const float* const (&in)[27] = F.in; unsigned char* ws = F.ws;
    for (int idx = F.gt; idx < 32 * 128 * 32; idx += F.NGT) {
        const int c4 = (idx & 31) * 4, r = (idx >> 5) & 127, bb = idx >> 12, kvh = c4 >> 6, d0 = c4 & 63;
        const f32x4 k = *(const f32x4*)(in[I_CK] + (size_t)(bb * 128 + r) * 128 + c4), v = *(const f32x4*)(in[I_CV] + (size_t)(bb * 128 + r) * 128 + c4);
        const size_t blk = (size_t)((bb * 2 + kvh) * 6 + (r >> 5));
        v2u w; w.x = pk2(k.x, k.y); w.y = pk2(k.z, k.w);
        *(v2u*)((bf16*)(ws + WS_KBS) + ((blk * 4 + (d0 >> 4)) * 64 + ((d0 >> 3) & 1) * 32 + (r & 31)) * 8 + (d0 & 7)) = w;
        bf16* vf = (bf16*)(ws + WS_VTS) + blk * 2048;
        vf[vf_off(r, d0)] = f2bf(v.x); vf[vf_off(r, d0 + 1)] = f2bf(v.y); vf[vf_off(r, d0 + 2)] = f2bf(v.z); vf[vf_off(r, d0 + 3)] = f2bf(v.w);
        if (r >= 64) { *(f32x4*)(F.out + O_WKS + (size_t)(bb * 128 + r - 64) * 128 + c4) = k; *(f32x4*)(F.out + O_WVS + (size_t)(bb * 128 + r - 64) * 128 + c4) = v; }
    }
}
__device__ __forceinline__ void p0b_stream(Frame& F) {
    const float* const (&in)[27] = F.in; unsigned char* ws = F.ws;
    LAS float* scr = (LAS float*)(F.lds + F.wave * 16384);
    constexpr int I_IN = 16 * 40, I_GLU = 8 * 16, I_OUT = 16 * 32, NITEMS = I_IN + I_GLU + I_OUT;
    for (int it = F.gw; it < NITEMS; it += F.NGW) {
        int r = it;
        if (r < I_IN) { const int kb = r / 40, nb = r % 40; transpose_item(in[I_WIN], D, NPROJ, (bf16*)(ws + WS_WIN), 64 * kb, 32 * nb, 32 * nb, scr, F.lane); continue; } r -= I_IN;
        if (r < I_OUT) { const int kb = r / 32, nb = r % 32; transpose_item(in[I_WOUT], D, D, (bf16*)(ws + WS_WOUT), 64 * kb, 32 * nb, 32 * nb, scr, F.lane); continue; } r -= I_OUT;
        { const int kb = r / 16, nb = r % 16; transpose_item(in[I_WGLU], SSMW, SSMW, (bf16*)(ws + WS_WGLU), 64 * kb, 32 * nb, 32 * nb, scr, F.lane); }
    }
    for (int m = 4 * F.gw; m < M; m += 4 * F.NGW) {
        const float* xrow = m < MP ? in[I_XP] + (size_t)m * D : in[I_XS] + (size_t)(m - MP) * D;
        ln_rows4<true>(xrow, D, in[I_LNG], in[I_LNB], (bf16*)(ws + WS_X0) + (size_t)m * D, D, F.lane);
    }
}

constexpr int LDS_BB = 131072, LDS_PL = 131072 + 8192;
__device__ __forceinline__ void p1_group_prepare(Frame& F, int g) {
    const float* const (&in)[27] = F.in;
    LAS f32x2* BB = (LAS f32x2*)(F.lds + LDS_BB); LAS f32x2* PL = (LAS f32x2*)(F.lds + LDS_PL);
    for (int e = F.tid; e < 64 * 17; e += NTHR) { float re, im; ssm_polar(in, g, e / 17, (float)(e % 17), re, im); PL[e] = (f32x2){re, im}; }
    for (int e = F.tid; e < 64 * 16; e += NTHR) { const int p = e >> 4, gp = g * 64 + p; float ar, ai; ssm_polar(in, g, p, 1.f, ar, ai);
        const float lr = in[I_LRE][gp], li = in[I_LIM][gp], nr = ar - 1.0f, ni = ai, den = lr * lr + li * li;
        const float fr = (nr * lr + ni * li) / den, fi = (ni * lr - nr * li) / den;
        const float br = in[I_BRE][gp * 16 + (e & 15)], bi = in[I_BIM][gp * 16 + (e & 15)];
        BB[e] = (f32x2){fr * br - fi * bi, fr * bi + fi * br}; }
}
__device__ __forceinline__ void p1_tables(Frame& F, int g, int part) {
    const float* const (&in)[27] = F.in; unsigned char* ws = F.ws;
    const LAS f32x2* BBAR = (const LAS f32x2*)(F.lds + LDS_BB); const LAS f32x2* POWL = (const LAS f32x2*)(F.lds + LDS_PL);
    bf16* TZT = (bf16*)(ws + WS_TZT); bf16* W1T = (bf16*)(ws + WS_W1T); bf16* W3P = (bf16*)(ws + WS_W3P);
    for (int li = part * 264 + F.tid; li < (part + 1) * 264; li += NTHR) { const int p = li / 33, n = li % 33; float re, im;
        ssm_polar(in, g, p, 16.f * (float)n, re, im); ((f32x2*)(ws + WS_POW16))[(g * 33 + n) * 64 + p] = (f32x2){re, im}; }
    for (int li = part * 992 + F.tid; li < (part + 1) * 992; li += NTHR) {
        const int cp = li & 15, c = (li >> 4) & 15, dl = (li >> 8) - 15;
#define TZ_OFF(t, s) ((((size_t)((g * 8 + ((t) >> 1)) * 16 + (s))) * 64 + (cp >> 3) * 32 + 16 * ((t) & 1) + c) * 8 + (cp & 7))
        if (dl < 0) { for (int t = 0; t <= 15 + dl; ++t) TZT[TZ_OFF(t, t - dl)] = 0; continue; }
        float acc = 0.f;
        for (int p = 0; p < 64; ++p) {
            const float cr = in[I_CRE][(g * 16 + c) * 64 + p], ci = in[I_CIM][(g * 16 + c) * 64 + p];
            const f32x2 bb = BBAR[p * 16 + cp], pw = POWL[p * 17 + dl];
            const float zr = bb.x * pw.x - bb.y * pw.y, zi = bb.x * pw.y + bb.y * pw.x;
            acc += cr * zr - ci * zi;
        }
        if (dl == 0 && c == cp) acc += in[I_DSK][g * 16 + c];
        const bf16 v = f2bf(acc);
        for (int s = 0; s <= 15 - dl; ++s) TZT[TZ_OFF(s + dl, s)] = v;
#undef TZ_OFF
    }
    for (int li = part * 128 + F.tid; li < (part + 1) * 128; li += NTHR) {
        const int s = li & 15, p = li >> 4; const f32x2 pw = POWL[p * 17 + 15 - s];
        unsigned wr_[8], wi_[8];
#pragma unroll
        for (int c2 = 0; c2 < 8; ++c2) { const f32x2 b0 = BBAR[p * 16 + 2 * c2], b1 = BBAR[p * 16 + 2 * c2 + 1];
            wr_[c2] = pk2(b0.x * pw.x - b0.y * pw.y, b1.x * pw.x - b1.y * pw.y); wi_[c2] = pk2(b0.x * pw.y + b0.y * pw.x, b1.x * pw.y + b1.y * pw.x); }
        const int pp = 2 * p, rbk = pp >> 5, rr = pp & 31;
        v4u* d0 = (v4u*)(W1T + ((size_t)((g * 4 + rbk) * 16 + s) * 64 + rr) * 8); v4u* d1 = (v4u*)(W1T + ((size_t)((g * 4 + rbk) * 16 + s) * 64 + rr + 1) * 8);
        d0[0] = (v4u){wr_[0], wr_[1], wr_[2], wr_[3]}; d0[32] = (v4u){wr_[4], wr_[5], wr_[6], wr_[7]};
        d1[0] = (v4u){wi_[0], wi_[1], wi_[2], wi_[3]}; d1[32] = (v4u){wi_[4], wi_[5], wi_[6], wi_[7]};
    }
    for (int li = part * 2048 + F.tid; li < (part + 1) * 2048; li += NTHR) {
        const int p = li & 63, row = li >> 6, t = row >> 4, c = row & 15;
        const float cr = in[I_CRE][(g * 16 + c) * 64 + p], ci = in[I_CIM][(g * 16 + c) * 64 + p]; const f32x2 pw = POWL[p * 17 + t + 1];
        const float zr = cr * pw.x - ci * pw.y, zi = cr * pw.y + ci * pw.x;
        const int pp = 2 * p, rb = pp >> 5, w = pp & 31;
        *(unsigned*)(W3P + ((size_t)((((g * 8 + (row >> 5)) * 4 + rb) * 2 + (w >> 4))) * 64 + ((w >> 2) & 1) * 32 + (row & 31)) * 8 + 4 * ((w >> 3) & 1) + (w & 3)) = pk2(zr, -zi);
    }
}

#ifndef REP_P0
#define REP_P0 1
#endif
#ifndef REP_P1
#define REP_P1 1
#endif
#ifndef REP_P2
#define REP_P2 1
#endif
#ifndef REP_P3
#define REP_P3 1
#endif
#ifndef REP_P4
#define REP_P4 1
#endif
#ifndef REP_P5
#define REP_P5 1
#endif
#ifndef REP_P6
#define REP_P6 1
#endif
#ifndef REP_P7
#define REP_P7 1
#endif
#ifndef REP_P8
#define REP_P8 1
#endif
#ifndef REP_P9
#define REP_P9 1
#endif
#ifndef REP_P1T
#define REP_P1T 1
#endif
#ifndef REP_S1
#define REP_S1 1
#endif
#ifndef REP_S3
#define REP_S3 1
#endif
#ifndef REP_FFNW
#define REP_FFNW 1
#endif
#ifndef REP_ATT
#define REP_ATT 1
#endif
#ifndef REP_SSMX
#define REP_SSMX 1
#endif
#ifndef REP_SYNC
#define REP_SYNC 1
#endif
#ifndef REP_SYNCCG
#define REP_SYNCCG 1
#endif
#define GSYNC_CG() do { for (int s_ = 0; s_ < REP_SYNCCG; ++s_) grid.sync(); } while (0)
#define GSYNC() do { for (int s_ = 0; s_ < REP_SYNC; ++s_) xcd_barrier(bar); } while (0)
#define PIN8(a) asm volatile("" : "+v"(a[0]), "+v"(a[1]), "+v"(a[2]), "+v"(a[3]), "+v"(a[4]), "+v"(a[5]), "+v"(a[6]), "+v"(a[7]))
__device__ __forceinline__ void attn_wave(Frame& F, int au) {
    bf16* MIX = (bf16*)(F.ws + WS_MIX);
    const int lane = F.lane, r = lane & 31, h = lane >> 5;
    const int cgl = au >> 1, kvh = au & 1, qh = F.wave >> 2, head = kvh * 4 + (F.wave & 3);
    int row0, kb0; const bf16* kf0; const bf16* vf0;
    if (cgl < 256) { const int b = cgl >> 6, c = cgl & 63; row0 = b * 4096 + c * 64 + qh * 32; kb0 = c >= 2 ? 0 : (c == 1 ? 2 : 4);
        const long blk = (long)(b * 2 + kvh) * 128 + (2 * c - 4);
        kf0 = (const bf16*)(F.ws + WS_KFP) + blk * 2048; vf0 = (const bf16*)(F.ws + WS_VFP) + blk * 2048;
    } else { const int b = cgl - 256; row0 = MP + b * 64 + qh * 32; kb0 = 0;
        const long blk = (long)(b * 2 + kvh) * 6;
        kf0 = (const bf16*)(F.ws + WS_KBS) + blk * 2048; vf0 = (const bf16*)(F.ws + WS_VTS) + blk * 2048; }
    bf16x8 qf[4];
#pragma unroll
    for (int kk = 0; kk < 4; ++kk) qf[kk] = *(const bf16x8*)((const bf16*)(F.ws + WS_QF) + ((size_t)(((row0 >> 5) * 8 + head) * 4 + kk) * 64 + lane) * 8);
    f32x16 s[6];
    { bf16x8 f[2][8];
#pragma unroll
      for (int i = 0; i < 8; ++i) { f[0][i] = (bf16x8){0, 0, 0, 0, 0, 0, 0, 0}; f[1][i] = f[0][i]; }
      if (kb0 == 0) {
#pragma unroll
          for (int i = 0; i < 8; ++i) f[0][i] = *(const bf16x8*)(kf0 + (i * 64 + lane) * 8); }
#pragma unroll
      for (int bt = 0; bt < 3; ++bt) {
          if (bt < 2 && 2 * (bt + 1) >= kb0) {
#pragma unroll
              for (int i = 0; i < 8; ++i) f[(bt + 1) & 1][i] = *(const bf16x8*)(kf0 + (((bt + 1) * 8 + i) * 64 + lane) * 8); }
          if (2 * bt >= kb0) {
              PIN8(f[bt & 1]);
#pragma unroll
              for (int k2 = 0; k2 < 2; ++k2) { f32x16 acc;
#pragma unroll
                  for (int i = 0; i < 16; ++i) acc[i] = 0.f;
#pragma unroll
                  for (int kk = 0; kk < 4; ++kk) acc = MFMA32(f[bt & 1][k2 * 4 + kk], qf[kk], acc);
#pragma unroll
                  for (int i = 0; i < 16; ++i) s[2 * bt + k2][i] = acc[i] * 0.125f; }
          } else {
#pragma unroll
              for (int k2 = 0; k2 < 2; ++k2)
#pragma unroll
                  for (int i = 0; i < 16; ++i) s[2 * bt + k2][i] = -1e30f;
          }
      } }
    const float sink = F.in[I_SINK][head];
    float mx = sink;
#pragma unroll
    for (int kb = 0; kb < 6; ++kb)
#pragma unroll
        for (int i = 0; i < 16; ++i) mx = fmaxf(mx, s[kb][i]);
    mx = fmaxf(mx, __shfl_xor(mx, 32));
    float l = 0.f;
#pragma unroll
    for (int kb = 0; kb < 6; ++kb)
#pragma unroll
        for (int i = 0; i < 16; ++i) { const float p = __expf(s[kb][i] - mx); s[kb][i] = p; l += p; }
    l += __shfl_xor(l, 32); l += __expf(sink - mx);
    f32x16 o[2];
#pragma unroll
    for (int i = 0; i < 16; ++i) { o[0][i] = 0.f; o[1][i] = 0.f; }
    { bf16x8 f[2][8];
#pragma unroll
      for (int i = 0; i < 8; ++i) { f[0][i] = (bf16x8){0, 0, 0, 0, 0, 0, 0, 0}; f[1][i] = f[0][i]; }
      if (kb0 == 0) {
#pragma unroll
          for (int i = 0; i < 8; ++i) f[0][i] = *(const bf16x8*)(vf0 + (i * 64 + lane) * 8); }
#pragma unroll
      for (int bt = 0; bt < 3; ++bt) {
          if (bt < 2 && 2 * (bt + 1) >= kb0) {
#pragma unroll
              for (int i = 0; i < 8; ++i) f[(bt + 1) & 1][i] = *(const bf16x8*)(vf0 + (((bt + 1) * 8 + i) * 64 + lane) * 8); }
          if (2 * bt >= kb0) {
              PIN8(f[bt & 1]);
#pragma unroll
              for (int k2 = 0; k2 < 2; ++k2)
#pragma unroll
                  for (int s2 = 0; s2 < 2; ++s2) { const int kb = 2 * bt + k2;
                      v4u pw; pw.x = pk2(s[kb][8 * s2 + 0], s[kb][8 * s2 + 1]); pw.y = pk2(s[kb][8 * s2 + 2], s[kb][8 * s2 + 3]); pw.z = pk2(s[kb][8 * s2 + 4], s[kb][8 * s2 + 5]); pw.w = pk2(s[kb][8 * s2 + 6], s[kb][8 * s2 + 7]);
                      const bf16x8 pf = __builtin_bit_cast(bf16x8, pw);
#pragma unroll
                      for (int db = 0; db < 2; ++db) o[db] = MFMA32(f[bt & 1][(k2 * 2 + s2) * 2 + db], pf, o[db]); }
          }
      } }
    const float inv = 1.0f / l;
#pragma unroll
    for (int db = 0; db < 2; ++db)
#pragma unroll
        for (int qq = 0; qq < 4; ++qq) { v2u w; w.x = pk2(o[db][4 * qq] * inv, o[db][4 * qq + 1] * inv); w.y = pk2(o[db][4 * qq + 2] * inv, o[db][4 * qq + 3] * inv);
            *(v2u*)(MIX + (size_t)(row0 + r) * D + head * 64 + 32 * db + 8 * qq + 4 * h) = w; }
}

template <int CTRL, int ROWMASK>
__device__ __forceinline__ float dppf(float v) { return __int_as_float(__builtin_amdgcn_update_dpp(0, __float_as_int(v), CTRL, ROWMASK, 0xf, false)); }
constexpr int SSM_T_BYTES = 17408;
constexpr int ATT_SPLIT = 352;
template <int B8>
__device__ __forceinline__ void ssm_rowblock(const bf16* TZT, const bf16* W3P, bf16* YS, const bf16x8 (&uf)[16], const bf16x8 (&hf)[4][2], int g, int lane, int r, int h, int tok0) {
    constexpr int NT = 2 * B8 + 2, N = NT + 8, NBT = (N + 7) / 8;
    f32x16 acc;
#pragma unroll
    for (int i = 0; i < 16; ++i) acc[i] = 0.f;
    const bf16* trow = TZT + ((size_t)(g * 8 + B8) * 16 * 64 + lane) * 8; const bf16* wrow = W3P + ((size_t)(g * 8 + B8) * 8 * 64 + lane) * 8;
    bf16x8 f[2][8];
#pragma unroll
    for (int i = 0; i < 8; ++i) { f[0][i] = (bf16x8){0, 0, 0, 0, 0, 0, 0, 0}; f[1][i] = f[0][i]; }
#pragma unroll
    for (int i = 0; i < 8; ++i) if (i < N) f[0][i] = i < NT ? *(const bf16x8*)(trow + i * 512) : *(const bf16x8*)(wrow + (i - NT) * 512);
#pragma unroll
    for (int bt = 0; bt < NBT; ++bt) {
#pragma unroll
        for (int i = 0; i < 8; ++i) { const int ix = (bt + 1) * 8 + i; if (ix < N) f[(bt + 1) & 1][i] = ix < NT ? *(const bf16x8*)(trow + ix * 512) : *(const bf16x8*)(wrow + (ix - NT) * 512); }
        PIN8(f[bt & 1]);
#pragma unroll
        for (int i = 0; i < 8; ++i) { const int ix = bt * 8 + i; if (ix < N) acc = MFMA32(f[bt & 1][i], ix < NT ? uf[ix < NT ? ix : 0] : hf[ix < NT ? 0 : (ix - NT) >> 1][(ix - NT) & 1], acc); }
    }
#pragma unroll
    for (int qq = 0; qq < 4; ++qq) { const int c0 = 8 * (qq & 1) + 4 * h, t = 2 * B8 + (qq >> 1);
        const pg8::f32x2 g0 = pg8::gelu_pk((pg8::f32x2){acc[4 * qq], acc[4 * qq + 1]}), g1 = pg8::gelu_pk((pg8::f32x2){acc[4 * qq + 2], acc[4 * qq + 3]});
        v2u w; w.x = pk2(g0.x, g0.y); w.y = pk2(g1.x, g1.y);
        *(v2u*)(YS + (size_t)(tok0 + 16 * r + t) * SSMW + 16 * g + c0) = w; }
}
__device__ __forceinline__ void ssm_step3(const bf16* TZT, const bf16* W3P, bf16* YS, const bf16x8 (&uf)[16], const bf16x8 (&hf)[4][2], int g, int lane, int r, int h, int tok0) {
    const bf16* tz = TZT + ((size_t)(g * 8) * 16 * 64 + lane) * 8; const bf16* w3 = W3P + ((size_t)(g * 8) * 8 * 64 + lane) * 8;
    bf16x8 fa[8], fb[8]; f32x16 acc;
#pragma unroll
    for (int i = 0; i < 16; ++i) acc[i] = 0.f;
#define S3_EPI(B8) { _Pragma("unroll") for (int qq = 0; qq < 4; ++qq) { const int c0 = 8 * (qq & 1) + 4 * h, t = 2 * (B8) + (qq >> 1); \
        const pg8::f32x2 g0 = pg8::gelu_pk((pg8::f32x2){acc[4 * qq], acc[4 * qq + 1]}), g1 = pg8::gelu_pk((pg8::f32x2){acc[4 * qq + 2], acc[4 * qq + 3]}); \
        v2u w; w.x = pk2(g0.x, g0.y); w.y = pk2(g1.x, g1.y); *(v2u*)(YS + (size_t)(tok0 + 16 * r + t) * SSMW + 16 * g + c0) = w; } \
        _Pragma("unroll") for (int k = 0; k < 16; ++k) acc[k] = 0.f; }
    fa[0] = *(const bf16x8*)(tz + 0); fa[1] = *(const bf16x8*)(tz + 512); fa[2] = *(const bf16x8*)(w3 + 0); fa[3] = *(const bf16x8*)(w3 + 512); fa[4] = *(const bf16x8*)(w3 + 1024); fa[5] = *(const bf16x8*)(w3 + 1536); fa[6] = *(const bf16x8*)(w3 + 2048); fa[7] = *(const bf16x8*)(w3 + 2560);
    fb[0] = *(const bf16x8*)(w3 + 3072); fb[1] = *(const bf16x8*)(w3 + 3584); fb[2] = *(const bf16x8*)(tz + 8192); fb[3] = *(const bf16x8*)(tz + 8704); fb[4] = *(const bf16x8*)(tz + 9216); fb[5] = *(const bf16x8*)(tz + 9728); fb[6] = *(const bf16x8*)(w3 + 4096); fb[7] = *(const bf16x8*)(w3 + 4608);
    PIN8(fa);
    acc = MFMA32(fa[0], uf[0], acc); acc = MFMA32(fa[1], uf[1], acc); acc = MFMA32(fa[2], hf[0][0], acc); acc = MFMA32(fa[3], hf[0][1], acc); acc = MFMA32(fa[4], hf[1][0], acc); acc = MFMA32(fa[5], hf[1][1], acc); acc = MFMA32(fa[6], hf[2][0], acc); acc = MFMA32(fa[7], hf[2][1], acc);
    fa[0] = *(const bf16x8*)(w3 + 5120); fa[1] = *(const bf16x8*)(w3 + 5632); fa[2] = *(const bf16x8*)(w3 + 6144); fa[3] = *(const bf16x8*)(w3 + 6656); fa[4] = *(const bf16x8*)(w3 + 7168); fa[5] = *(const bf16x8*)(w3 + 7680); fa[6] = *(const bf16x8*)(tz + 16384); fa[7] = *(const bf16x8*)(tz + 16896);
    PIN8(fb);
    acc = MFMA32(fb[0], hf[3][0], acc); acc = MFMA32(fb[1], hf[3][1], acc); S3_EPI(0) acc = MFMA32(fb[2], uf[0], acc); acc = MFMA32(fb[3], uf[1], acc); acc = MFMA32(fb[4], uf[2], acc); acc = MFMA32(fb[5], uf[3], acc); acc = MFMA32(fb[6], hf[0][0], acc); acc = MFMA32(fb[7], hf[0][1], acc);
    fb[0] = *(const bf16x8*)(tz + 17408); fb[1] = *(const bf16x8*)(tz + 17920); fb[2] = *(const bf16x8*)(tz + 18432); fb[3] = *(const bf16x8*)(tz + 18944); fb[4] = *(const bf16x8*)(w3 + 8192); fb[5] = *(const bf16x8*)(w3 + 8704); fb[6] = *(const bf16x8*)(w3 + 9216); fb[7] = *(const bf16x8*)(w3 + 9728);
    PIN8(fa);
    acc = MFMA32(fa[0], hf[1][0], acc); acc = MFMA32(fa[1], hf[1][1], acc); acc = MFMA32(fa[2], hf[2][0], acc); acc = MFMA32(fa[3], hf[2][1], acc); acc = MFMA32(fa[4], hf[3][0], acc); acc = MFMA32(fa[5], hf[3][1], acc); S3_EPI(1) acc = MFMA32(fa[6], uf[0], acc); acc = MFMA32(fa[7], uf[1], acc);
    fa[0] = *(const bf16x8*)(w3 + 10240); fa[1] = *(const bf16x8*)(w3 + 10752); fa[2] = *(const bf16x8*)(w3 + 11264); fa[3] = *(const bf16x8*)(w3 + 11776); fa[4] = *(const bf16x8*)(tz + 24576); fa[5] = *(const bf16x8*)(tz + 25088); fa[6] = *(const bf16x8*)(tz + 25600); fa[7] = *(const bf16x8*)(tz + 26112);
    PIN8(fb);
    acc = MFMA32(fb[0], uf[2], acc); acc = MFMA32(fb[1], uf[3], acc); acc = MFMA32(fb[2], uf[4], acc); acc = MFMA32(fb[3], uf[5], acc); acc = MFMA32(fb[4], hf[0][0], acc); acc = MFMA32(fb[5], hf[0][1], acc); acc = MFMA32(fb[6], hf[1][0], acc); acc = MFMA32(fb[7], hf[1][1], acc);
    fb[0] = *(const bf16x8*)(tz + 26624); fb[1] = *(const bf16x8*)(tz + 27136); fb[2] = *(const bf16x8*)(tz + 27648); fb[3] = *(const bf16x8*)(tz + 28160); fb[4] = *(const bf16x8*)(w3 + 12288); fb[5] = *(const bf16x8*)(w3 + 12800); fb[6] = *(const bf16x8*)(w3 + 13312); fb[7] = *(const bf16x8*)(w3 + 13824);
    PIN8(fa);
    acc = MFMA32(fa[0], hf[2][0], acc); acc = MFMA32(fa[1], hf[2][1], acc); acc = MFMA32(fa[2], hf[3][0], acc); acc = MFMA32(fa[3], hf[3][1], acc); S3_EPI(2) acc = MFMA32(fa[4], uf[0], acc); acc = MFMA32(fa[5], uf[1], acc); acc = MFMA32(fa[6], uf[2], acc); acc = MFMA32(fa[7], uf[3], acc);
    fa[0] = *(const bf16x8*)(w3 + 14336); fa[1] = *(const bf16x8*)(w3 + 14848); fa[2] = *(const bf16x8*)(w3 + 15360); fa[3] = *(const bf16x8*)(w3 + 15872); fa[4] = *(const bf16x8*)(tz + 32768); fa[5] = *(const bf16x8*)(tz + 33280); fa[6] = *(const bf16x8*)(tz + 33792); fa[7] = *(const bf16x8*)(tz + 34304);
    PIN8(fb);
    acc = MFMA32(fb[0], uf[4], acc); acc = MFMA32(fb[1], uf[5], acc); acc = MFMA32(fb[2], uf[6], acc); acc = MFMA32(fb[3], uf[7], acc); acc = MFMA32(fb[4], hf[0][0], acc); acc = MFMA32(fb[5], hf[0][1], acc); acc = MFMA32(fb[6], hf[1][0], acc); acc = MFMA32(fb[7], hf[1][1], acc);
    fb[0] = *(const bf16x8*)(tz + 34816); fb[1] = *(const bf16x8*)(tz + 35328); fb[2] = *(const bf16x8*)(tz + 35840); fb[3] = *(const bf16x8*)(tz + 36352); fb[4] = *(const bf16x8*)(tz + 36864); fb[5] = *(const bf16x8*)(tz + 37376); fb[6] = *(const bf16x8*)(w3 + 16384); fb[7] = *(const bf16x8*)(w3 + 16896);
    PIN8(fa);
    acc = MFMA32(fa[0], hf[2][0], acc); acc = MFMA32(fa[1], hf[2][1], acc); acc = MFMA32(fa[2], hf[3][0], acc); acc = MFMA32(fa[3], hf[3][1], acc); S3_EPI(3) acc = MFMA32(fa[4], uf[0], acc); acc = MFMA32(fa[5], uf[1], acc); acc = MFMA32(fa[6], uf[2], acc); acc = MFMA32(fa[7], uf[3], acc);
    fa[0] = *(const bf16x8*)(w3 + 17408); fa[1] = *(const bf16x8*)(w3 + 17920); fa[2] = *(const bf16x8*)(w3 + 18432); fa[3] = *(const bf16x8*)(w3 + 18944); fa[4] = *(const bf16x8*)(w3 + 19456); fa[5] = *(const bf16x8*)(w3 + 19968); fa[6] = *(const bf16x8*)(tz + 40960); fa[7] = *(const bf16x8*)(tz + 41472);
    PIN8(fb);
    acc = MFMA32(fb[0], uf[4], acc); acc = MFMA32(fb[1], uf[5], acc); acc = MFMA32(fb[2], uf[6], acc); acc = MFMA32(fb[3], uf[7], acc); acc = MFMA32(fb[4], uf[8], acc); acc = MFMA32(fb[5], uf[9], acc); acc = MFMA32(fb[6], hf[0][0], acc); acc = MFMA32(fb[7], hf[0][1], acc);
    fb[0] = *(const bf16x8*)(tz + 41984); fb[1] = *(const bf16x8*)(tz + 42496); fb[2] = *(const bf16x8*)(tz + 43008); fb[3] = *(const bf16x8*)(tz + 43520); fb[4] = *(const bf16x8*)(tz + 44032); fb[5] = *(const bf16x8*)(tz + 44544); fb[6] = *(const bf16x8*)(tz + 45056); fb[7] = *(const bf16x8*)(tz + 45568);
    PIN8(fa);
    acc = MFMA32(fa[0], hf[1][0], acc); acc = MFMA32(fa[1], hf[1][1], acc); acc = MFMA32(fa[2], hf[2][0], acc); acc = MFMA32(fa[3], hf[2][1], acc); acc = MFMA32(fa[4], hf[3][0], acc); acc = MFMA32(fa[5], hf[3][1], acc); S3_EPI(4) acc = MFMA32(fa[6], uf[0], acc); acc = MFMA32(fa[7], uf[1], acc);
    fa[0] = *(const bf16x8*)(tz + 46080); fa[1] = *(const bf16x8*)(tz + 46592); fa[2] = *(const bf16x8*)(w3 + 20480); fa[3] = *(const bf16x8*)(w3 + 20992); fa[4] = *(const bf16x8*)(w3 + 21504); fa[5] = *(const bf16x8*)(w3 + 22016); fa[6] = *(const bf16x8*)(w3 + 22528); fa[7] = *(const bf16x8*)(w3 + 23040);
    PIN8(fb);
    acc = MFMA32(fb[0], uf[2], acc); acc = MFMA32(fb[1], uf[3], acc); acc = MFMA32(fb[2], uf[4], acc); acc = MFMA32(fb[3], uf[5], acc); acc = MFMA32(fb[4], uf[6], acc); acc = MFMA32(fb[5], uf[7], acc); acc = MFMA32(fb[6], uf[8], acc); acc = MFMA32(fb[7], uf[9], acc);
    fb[0] = *(const bf16x8*)(w3 + 23552); fb[1] = *(const bf16x8*)(w3 + 24064); fb[2] = *(const bf16x8*)(tz + 49152); fb[3] = *(const bf16x8*)(tz + 49664); fb[4] = *(const bf16x8*)(tz + 50176); fb[5] = *(const bf16x8*)(tz + 50688); fb[6] = *(const bf16x8*)(tz + 51200); fb[7] = *(const bf16x8*)(tz + 51712);
    PIN8(fa);
    acc = MFMA32(fa[0], uf[10], acc); acc = MFMA32(fa[1], uf[11], acc); acc = MFMA32(fa[2], hf[0][0], acc); acc = MFMA32(fa[3], hf[0][1], acc); acc = MFMA32(fa[4], hf[1][0], acc); acc = MFMA32(fa[5], hf[1][1], acc); acc = MFMA32(fa[6], hf[2][0], acc); acc = MFMA32(fa[7], hf[2][1], acc);
    fa[0] = *(const bf16x8*)(tz + 52224); fa[1] = *(const bf16x8*)(tz + 52736); fa[2] = *(const bf16x8*)(tz + 53248); fa[3] = *(const bf16x8*)(tz + 53760); fa[4] = *(const bf16x8*)(tz + 54272); fa[5] = *(const bf16x8*)(tz + 54784); fa[6] = *(const bf16x8*)(tz + 55296); fa[7] = *(const bf16x8*)(tz + 55808);
    PIN8(fb);
    acc = MFMA32(fb[0], hf[3][0], acc); acc = MFMA32(fb[1], hf[3][1], acc); S3_EPI(5) acc = MFMA32(fb[2], uf[0], acc); acc = MFMA32(fb[3], uf[1], acc); acc = MFMA32(fb[4], uf[2], acc); acc = MFMA32(fb[5], uf[3], acc); acc = MFMA32(fb[6], uf[4], acc); acc = MFMA32(fb[7], uf[5], acc);
    fb[0] = *(const bf16x8*)(w3 + 24576); fb[1] = *(const bf16x8*)(w3 + 25088); fb[2] = *(const bf16x8*)(w3 + 25600); fb[3] = *(const bf16x8*)(w3 + 26112); fb[4] = *(const bf16x8*)(w3 + 26624); fb[5] = *(const bf16x8*)(w3 + 27136); fb[6] = *(const bf16x8*)(w3 + 27648); fb[7] = *(const bf16x8*)(w3 + 28160);
    PIN8(fa);
    acc = MFMA32(fa[0], uf[6], acc); acc = MFMA32(fa[1], uf[7], acc); acc = MFMA32(fa[2], uf[8], acc); acc = MFMA32(fa[3], uf[9], acc); acc = MFMA32(fa[4], uf[10], acc); acc = MFMA32(fa[5], uf[11], acc); acc = MFMA32(fa[6], uf[12], acc); acc = MFMA32(fa[7], uf[13], acc);
    fa[0] = *(const bf16x8*)(tz + 57344); fa[1] = *(const bf16x8*)(tz + 57856); fa[2] = *(const bf16x8*)(tz + 58368); fa[3] = *(const bf16x8*)(tz + 58880); fa[4] = *(const bf16x8*)(tz + 59392); fa[5] = *(const bf16x8*)(tz + 59904); fa[6] = *(const bf16x8*)(tz + 60416); fa[7] = *(const bf16x8*)(tz + 60928);
    PIN8(fb);
    acc = MFMA32(fb[0], hf[0][0], acc); acc = MFMA32(fb[1], hf[0][1], acc); acc = MFMA32(fb[2], hf[1][0], acc); acc = MFMA32(fb[3], hf[1][1], acc); acc = MFMA32(fb[4], hf[2][0], acc); acc = MFMA32(fb[5], hf[2][1], acc); acc = MFMA32(fb[6], hf[3][0], acc); acc = MFMA32(fb[7], hf[3][1], acc); S3_EPI(6)
    fb[0] = *(const bf16x8*)(tz + 61440); fb[1] = *(const bf16x8*)(tz + 61952); fb[2] = *(const bf16x8*)(tz + 62464); fb[3] = *(const bf16x8*)(tz + 62976); fb[4] = *(const bf16x8*)(tz + 63488); fb[5] = *(const bf16x8*)(tz + 64000); fb[6] = *(const bf16x8*)(tz + 64512); fb[7] = *(const bf16x8*)(tz + 65024);
    PIN8(fa);
    acc = MFMA32(fa[0], uf[0], acc); acc = MFMA32(fa[1], uf[1], acc); acc = MFMA32(fa[2], uf[2], acc); acc = MFMA32(fa[3], uf[3], acc); acc = MFMA32(fa[4], uf[4], acc); acc = MFMA32(fa[5], uf[5], acc); acc = MFMA32(fa[6], uf[6], acc); acc = MFMA32(fa[7], uf[7], acc);
    fa[0] = *(const bf16x8*)(w3 + 28672); fa[1] = *(const bf16x8*)(w3 + 29184); fa[2] = *(const bf16x8*)(w3 + 29696); fa[3] = *(const bf16x8*)(w3 + 30208); fa[4] = *(const bf16x8*)(w3 + 30720); fa[5] = *(const bf16x8*)(w3 + 31232); fa[6] = *(const bf16x8*)(w3 + 31744); fa[7] = *(const bf16x8*)(w3 + 32256);
    PIN8(fb);
    acc = MFMA32(fb[0], uf[8], acc); acc = MFMA32(fb[1], uf[9], acc); acc = MFMA32(fb[2], uf[10], acc); acc = MFMA32(fb[3], uf[11], acc); acc = MFMA32(fb[4], uf[12], acc); acc = MFMA32(fb[5], uf[13], acc); acc = MFMA32(fb[6], uf[14], acc); acc = MFMA32(fb[7], uf[15], acc);
    PIN8(fa);
    acc = MFMA32(fa[0], hf[0][0], acc); acc = MFMA32(fa[1], hf[0][1], acc); acc = MFMA32(fa[2], hf[1][0], acc); acc = MFMA32(fa[3], hf[1][1], acc); acc = MFMA32(fa[4], hf[2][0], acc); acc = MFMA32(fa[5], hf[2][1], acc); acc = MFMA32(fa[6], hf[3][0], acc); acc = MFMA32(fa[7], hf[3][1], acc); S3_EPI(7)
#undef S3_EPI
}
__device__ __forceinline__ void ssm_wg(Frame& F, int wgu) {
    const bf16* UF = (const bf16*)(F.ws + WS_UF); const bf16* W1T = (const bf16*)(F.ws + WS_W1T); const bf16* TZT = (const bf16*)(F.ws + WS_TZT); const bf16* W3P = (const bf16*)(F.ws + WS_W3P);
    const f32x2* POW16 = (const f32x2*)(F.ws + WS_POW16); bf16* YS = (bf16*)(F.ws + WS_YS);
    LAS f32x2* T = (LAS f32x2*)(F.lds + F.wave * SSM_T_BYTES);
    LAS f32x2* EX = (LAS f32x2*)(F.lds + 8 * SSM_T_BYTES);
    const int lane = F.lane, r = lane & 31, h = lane >> 5;
    const bool prompt = wgu < 128;
    int g, tok0, b = 0, q = 0; const int j = F.wave;
    if (prompt) { b = wgu >> 5; g = wgu & 31; tok0 = b * 4096 + j * 512; }
    else { const int s_ = (wgu - 128) * 8 + F.wave; g = s_ & 31; q = s_ >> 5; tok0 = MP + q * 512; }
    const int sp = prompt ? r : (r & 3);
    if (j < 7) EX[j * 64 + lane] = (f32x2){0.f, 0.f};
#pragma unroll 11
    for (int n = 0; n < 33; ++n) T[n * 65 + lane] = POW16[(size_t)(g * 33 + n) * 64 + lane];
    bf16x8 uf[16];
#pragma unroll
    for (int ks = 0; ks < 16; ++ks) uf[ks] = *(const bf16x8*)(UF + ((size_t)(((tok0 >> 9) * 32 + g) * 16 + ks) * 64 + lane) * 8);
    f32x16 x[4];
    for (int r1_ = 0; r1_ < REP_S1; ++r1_)
    { const bf16* w1 = W1T + ((size_t)(g * 4) * 16 * 64 + lane) * 8;
      bf16x8 f[2][8];
#pragma unroll
      for (int i = 0; i < 8; ++i) f[0][i] = *(const bf16x8*)(w1 + i * 512);
#pragma unroll
      for (int bt = 0; bt < 8; ++bt) { const int rb = bt >> 1;
          if ((bt & 1) == 0) {
#pragma unroll
              for (int i = 0; i < 16; ++i) x[rb][i] = 0.f; }
          if (bt < 7) {
#pragma unroll
              for (int i = 0; i < 8; ++i) f[(bt + 1) & 1][i] = *(const bf16x8*)(w1 + ((bt + 1) * 8 + i) * 512); }
          PIN8(f[bt & 1]);
#pragma unroll
          for (int i = 0; i < 8; ++i) x[rb] = MFMA32(f[bt & 1][i], uf[(bt & 1) * 8 + i], x[rb]); } }
    const int bb = 8 * q + (r >> 2);
    float dep[4] = {0.f, 0.f, 0.f, 0.f};
#pragma unroll
    for (int rb = 0; rb < 4; ++rb)
#pragma unroll
        for (int qp = 0; qp < 8; ++qp) {
            int hl = h; asm volatile("" : "+v"(hl), "+v"(dep[(rb * 8 + qp) & 3]));
            const int p = 16 * rb + (qp & 1) + 4 * (qp >> 1) + 2 * hl;
            const float xr = x[rb][2 * qp], xi = x[rb][2 * qp + 1];
            float zr = dppf<0x138, 0xf>(xr), zi = dppf<0x138, 0xf>(xi);
            if (sp == 0) { zr = 0.f; zi = 0.f; if (!prompt) { zr = F.in[I_SRE][(bb * 32 + g) * 64 + p]; zi = F.in[I_SIM][(bb * 32 + g) * 64 + p]; } }
#define SSM_LEVEL(d) { const f32x2 ad = T[(d) * 65 + p]; float pr = dppf<0x110 + (d), 0xf>(zr), pi = dppf<0x110 + (d), 0xf>(zi);     \
                if (!prompt && sp < (d)) { pr = 0.f; pi = 0.f; } zr += ad.x * pr - ad.y * pi; zi += ad.x * pi + ad.y * pr; }
            SSM_LEVEL(1) SSM_LEVEL(2)
            if (prompt) { SSM_LEVEL(4) SSM_LEVEL(8)
                const f32x2 am = T[((r & 15) + 1) * 65 + p]; const float br = dppf<0x142, 0xa>(zr), bi = dppf<0x142, 0xa>(zi);
                zr += am.x * br - am.y * bi; zi += am.x * bi + am.y * br; }
#undef SSM_LEVEL
            const f32x2 a1 = T[65 + p];
            const float er = a1.x * zr - a1.y * zi + xr, ei = a1.x * zi + a1.y * zr + xi;
            if (prompt) { if (r == 31) EX[(7 + j) * 64 + p] = (f32x2){er, ei}; }
            else if (sp == 3) { F.out[O_SRS + (size_t)(bb * 32 + g) * 64 + p] = er; F.out[O_SIS + (size_t)(bb * 32 + g) * 64 + p] = ei; }
            x[rb][2 * qp] = zr; x[rb][2 * qp + 1] = zi; dep[(rb * 8 + qp) & 3] = zr;
        }
    __syncthreads();
    if (prompt) {
#pragma unroll
        for (int rb = 0; rb < 4; ++rb)
#pragma unroll
            for (int qp = 0; qp < 8; ++qp) {
                int hl = h; asm volatile("" : "+v"(hl), "+v"(dep[(rb * 8 + qp) & 3]));
                const int p = 16 * rb + (qp & 1) + 4 * (qp >> 1) + 2 * hl; const f32x2 a5 = T[32 * 65 + p]; float c0 = 0.f, c1 = 0.f;
#pragma unroll
                for (int s7 = 0; s7 < 7; ++s7) { const f32x2 e = EX[(j + s7) * 64 + p];
                    const float nr = a5.x * c0 - a5.y * c1 + e.x, ni = a5.x * c1 + a5.y * c0 + e.y; c0 = nr; c1 = ni; }
                const f32x2 as = T[sp * 65 + p];
                x[rb][2 * qp] += as.x * c0 - as.y * c1; x[rb][2 * qp + 1] += as.x * c1 + as.y * c0; dep[(rb * 8 + qp) & 3] = x[rb][2 * qp];
                if (j == 7 && r == 31) { const f32x2 e = EX[14 * 64 + p]; F.out[O_SRP + (size_t)(b * 32 + g) * 64 + p] = e.x + a5.x * c0 - a5.y * c1; F.out[O_SIP + (size_t)(b * 32 + g) * 64 + p] = e.y + a5.x * c1 + a5.y * c0; }
            }
    }
    __syncthreads();
    asm volatile("" ::: "memory");
#pragma unroll
    for (int ks = 0; ks < 16; ++ks) uf[ks] = *(const bf16x8*)(UF + ((size_t)(((tok0 >> 9) * 32 + g) * 16 + ks) * 64 + lane) * 8);
    bf16x8 hf[4][2];
#pragma unroll
    for (int rb = 0; rb < 4; ++rb)
#pragma unroll
        for (int s2 = 0; s2 < 2; ++s2) { v4u w; w.x = pk2(x[rb][8 * s2 + 0], x[rb][8 * s2 + 1]); w.y = pk2(x[rb][8 * s2 + 2], x[rb][8 * s2 + 3]); w.z = pk2(x[rb][8 * s2 + 4], x[rb][8 * s2 + 5]); w.w = pk2(x[rb][8 * s2 + 6], x[rb][8 * s2 + 7]);
            hf[rb][s2] = __builtin_bit_cast(bf16x8, w); }
    ssm_step3(TZT, W3P, YS, uf, hf, g, lane, r, h, tok0);
}

#define XB_TMO      128
#define XB_XCNT(j)  (256  + 64 * (j))
#define XB_XSUB(j)  (1280 + 64 * (j))
#define XB_XGEN(j)  (2304 + 64 * (j))
#define XB_TOP      3328
#define XB_TOPGEN   3392
#define XCD_BAR_WORDS 3456
#define XB_SPIN_CAP (1u << 22)

__device__ __forceinline__ unsigned xb_ld(unsigned* p)              { return __hip_atomic_load(p, __ATOMIC_RELAXED, __HIP_MEMORY_SCOPE_AGENT); }
__device__ __forceinline__ unsigned xb_add(unsigned* p, unsigned v) { return __hip_atomic_fetch_add(p, v, __ATOMIC_RELAXED, __HIP_MEMORY_SCOPE_AGENT); }
__device__ __forceinline__ unsigned xb_xcc_id() { return (unsigned)__builtin_amdgcn_s_getreg((3 << 11) | 20) & 0xFu; }
#define XB_SPIN(cond, bar) do { unsigned _sp = 0; while (cond) { __builtin_amdgcn_s_sleep(1); \
    if ((++_sp & 255u) == 0u) { if (xb_ld(&(bar)[XB_TMO])) break; if (_sp > XB_SPIN_CAP) { atomicAdd(&(bar)[XB_TMO], 1u); break; } } } } while (0)

struct XcdBarrier {
    unsigned* bar; unsigned x;
    volatile LAS unsigned* st;
};

__device__ __forceinline__ XcdBarrier xcd_barrier_post(unsigned* bar, volatile LAS unsigned* st) {
    XcdBarrier b; b.bar = bar; b.x = xb_xcc_id(); b.st = st;
    if (threadIdx.x == 0) (void)xb_add(&bar[XB_XCNT(b.x)], 1u);
    return b;
}
__device__ __forceinline__ void xcd_barrier_complete(unsigned* bar, unsigned x, unsigned& nloc, unsigned& nx) {
    const unsigned G = gridDim.x * gridDim.y * gridDim.z;
    unsigned sum, cnt, mine, sp = 0u;
    for (;;) {
        sum = 0u; cnt = 0u; mine = 0u;
#pragma unroll
        for (unsigned j = 0; j < 16; ++j) { const unsigned c = xb_ld(&bar[XB_XCNT(j)]); sum += c; cnt += (c > 0u) ? 1u : 0u; mine = (j == x) ? c : mine; }
        if (sum == G) break;
        __builtin_amdgcn_s_sleep(1);
        if ((++sp & 255u) == 0u) { if (xb_ld(&bar[XB_TMO])) break; if (sp > XB_SPIN_CAP) { atomicAdd(&bar[XB_TMO], 1u); break; } }
    }
    nloc = mine > 0u ? mine : 1u; nx = cnt > 0u ? cnt : 1u;
}

__device__ __forceinline__ void xcd_barrier(const XcdBarrier& b) {
    asm volatile("s_waitcnt vmcnt(0)" ::: "memory");
    __syncthreads();
    if (threadIdx.x == 0) {
        unsigned* bar = b.bar;
        __builtin_amdgcn_s_waitcnt(0);
        unsigned nloc = b.st[0], nx = b.st[1];
        if (nloc == 0u) { xcd_barrier_complete(bar, b.x, nloc, nx); b.st[0] = nloc; b.st[1] = nx; }
        const unsigned old = xb_add(&bar[XB_XSUB(b.x)], 1u);
        const unsigned gen = old / nloc;
        if (old + 1u == (gen + 1u) * nloc) {
            __builtin_amdgcn_fence(__ATOMIC_RELEASE, "agent");
            asm volatile("s_waitcnt vmcnt(0)" ::: "memory");
            const unsigned og = xb_add(&bar[XB_TOP], 1u);
            const unsigned tg = og / nx;
            if (og + 1u == (tg + 1u) * nx) xb_add(&bar[XB_TOPGEN], 1u);
            else XB_SPIN(xb_ld(&bar[XB_TOPGEN]) == tg, bar);
            __builtin_amdgcn_fence(__ATOMIC_ACQUIRE, "agent");
            xb_add(&bar[XB_XGEN(b.x)], 1u);
            asm volatile("s_waitcnt vmcnt(0)" ::: "memory");
        } else {
            XB_SPIN(xb_ld(&bar[XB_XGEN(b.x)]) == gen, bar);
            __builtin_amdgcn_fence(__ATOMIC_ACQUIRE, "agent");
            asm volatile("s_waitcnt vmcnt(0)" ::: "memory");
        }
    }
    __syncthreads();
}

__global__ void __launch_bounds__(NTHR, 2) fwd_megakernel(Args args) {
    extern __shared__ __attribute__((aligned(16))) unsigned char lds[];
    cg::grid_group grid = cg::this_grid();
    Frame F;
    F.lds = (LAS unsigned char*)lds; F.tid = threadIdx.x; F.lane = F.tid & 63; F.wave = __builtin_amdgcn_readfirstlane(F.tid >> 6);
    F.G = gridDim.x; F.gw = blockIdx.x * NWAVES + F.wave; F.NGW = F.G * NWAVES; F.gt = blockIdx.x * NTHR + F.tid; F.NGT = F.G * NTHR;
    _Pragma("unroll") for (int i = 0; i < 27; ++i) F.in[i] = args.in[i];
    F.out = args.out; F.ws = args.ws;
    unsigned char* ws = args.ws;
    bf16* X0 = (bf16*)(ws + WS_X0); bf16* MIX = (bf16*)(ws + WS_MIX); bf16* YS = (bf16*)(ws + WS_YS); bf16* H = (bf16*)(ws + WS_H); bf16* ACT = (bf16*)(ws + WS_ACT);

    { volatile LAS unsigned* misc = (volatile LAS unsigned*)(F.lds + LDS_BYTES - 128); if (F.tid < 32) misc[F.tid] = 0u; }
    __syncthreads();
    const XcdBarrier bar = xcd_barrier_post((unsigned*)ws, (volatile LAS unsigned*)(F.lds + LDS_BYTES - 128));
#define REFRESH() do { int t_ = F.wave * 64 + pg8::lane_id_fresh(); F.tid = t_; F.lane = t_ & 63; F.gt = blockIdx.x * NTHR + t_; } while (0)
    for (int rep_ = 0; rep_ < REP_P0; ++rep_) {
    REFRESH();
    if (F.G >= 256) {
        const int v = blockIdx.x;
        if (v < 256) p1_group_prepare(F, v & 31);
        __syncthreads(); REFRESH();
        if (F.wave & 1) { p0b_stream(F); p0a_small(F); REFRESH(); if (v < 256) p1_tables(F, v & 31, v >> 5); }
        else { if (v < 256) p1_tables(F, v & 31, v >> 5); REFRESH(); p0b_stream(F); p0a_small(F); }
    } else {
        for (int v = blockIdx.x; v < 256; v += F.G) { p1_group_prepare(F, v & 31); __syncthreads(); p1_tables(F, v & 31, v >> 5); __syncthreads(); }
        REFRESH(); p0b_stream(F); p0a_small(F);
    }
    }
    if (F.G > 1000000) grid.sync();
    GSYNC();
    for (int rep_ = 0; rep_ < REP_P1; ++rep_) {
    REFRESH();
    { pg8::Gemm g{X0, (const bf16*)(ws + WS_WIN), M, NPROJ, D, D}; pg8::StaticOrder S; S.init(M, NPROJ, F.G, (int)blockIdx.x);
      EpiProj E{(bf16*)(ws + WS_QF), (bf16*)(ws + WS_UF), (bf16*)(ws + WS_KFP), (bf16*)(ws + WS_VFP), (bf16*)(ws + WS_KBS), (bf16*)(ws + WS_VTS), args.out};
      pg8::gemm_phase<EpiProj, pg8::StaticOrder, true, true>(F.lds, g, S, E, F.wave); }
    { const int nun = (M / 256) * (NPROJ / 256), first1 = nun > F.G ? nun - F.G : 0;
      REFRESH();
      if (first1 < F.G && (int)blockIdx.x >= first1) { for (int rw_ = 0; rw_ < REP_FFNW; ++rw_) p2_ffn_weights(F, ((int)blockIdx.x - first1) * NWAVES + F.wave, (F.G - first1) * NWAVES); }
      else if (first1 >= F.G) p2_ffn_weights(F, F.gw, F.NGW); }
    }
    GSYNC();
    for (int rep_ = 0; rep_ < REP_P2; ++rep_) {
    REFRESH();
    { const bool split = F.G >= 224;
      for (int rs_ = 0; rs_ < REP_SSMX; ++rs_)
      for (int u = blockIdx.x; u < 144; u += F.G) ssm_wg(F, u);
      REFRESH();
      for (int ra_ = 0; ra_ < REP_ATT; ++ra_) {
          if (!split) { for (int au = blockIdx.x; au < 576; au += F.G) attn_wave(F, au); }
          else if (blockIdx.x >= 144) for (int au = blockIdx.x - 144; au < ATT_SPLIT; au += F.G - 144) attn_wave(F, au); }
    }
    }
    GSYNC();
    for (int rep_ = 0; rep_ < REP_P4; ++rep_) {
    { pg8::Gemm g{YS, (const bf16*)(ws + WS_WGLU), M, SSMW, SSMW, SSMW}; pg8::StaticOrder S; S.init(M, SSMW, F.G, (int)blockIdx.x);
      EpiGlu E{YS, MIX, args.in[I_BGLU]};
      pg8::gemm_phase<EpiGlu, pg8::StaticOrder, true, true>(F.lds, g, S, E, F.wave); }
    if (F.G >= 224 && blockIdx.x >= 144) { REFRESH(); for (int au = ATT_SPLIT + (int)blockIdx.x - 144; au < 576; au += F.G - 144) attn_wave(F, au); }
    }
    GSYNC();
    for (int rep_ = 0; rep_ < REP_P5; ++rep_) {
    { pg8::Gemm g{MIX, (const bf16*)(ws + WS_WOUT), M, D, D, D}; MainTail S; S.init(F.G, (int)blockIdx.x, 16, 4, 4);
      EpiResTail E{X0, (bf16*)(ws + WS_PRE), (bf16*)(ws + WS_PART1) + (size_t)(blockIdx.x & 3) * MS * D};
      pg8::gemm_phase<EpiResTail, MainTail, true, true>(F.lds, g, S, E, F.wave); }
    }
    GSYNC();
    for (int rep_ = 0; rep_ < REP_P6; ++rep_) {
    REFRESH();
    for (int m = 4 * F.gw; m < MP; m += 4 * F.NGW) ln_rows4_b16((const bf16*)(ws + WS_PRE) + (size_t)m * D, args.in[I_L1G], args.in[I_L1B], H + (size_t)m * D, F.lane);
    for (int m = MP + F.gw; m < M; m += F.NGW) ln_row<true>(nullptr, args.in[I_L1G], args.in[I_L1B], H + (size_t)m * D, F.lane, (const bf16*)(ws + WS_PART1) + (size_t)(m - MP) * D, X0 + (size_t)m * D);
    }
    GSYNC();
    for (int rep_ = 0; rep_ < REP_P7; ++rep_) {
    { pg8::Gemm g{H, (const bf16*)(ws + WS_WGU), M, 2 * DFF, D, D}; pg8::StaticOrder S; S.init(M, 2 * DFF, F.G, (int)blockIdx.x);
      EpiSwiglu E{ACT};
      pg8::gemm_phase<EpiSwiglu, pg8::StaticOrder, true, true>(F.lds, g, S, E, F.wave); }
    }
    GSYNC();
    for (int rep_ = 0; rep_ < REP_P8; ++rep_) {
    { pg8::Gemm g{ACT, (const bf16*)(ws + WS_WDN), M, D, DFF, DFF}; MainTail S; S.init(F.G, (int)blockIdx.x, 44, 12, 10);
      EpiResTail E{H, (bf16*)(ws + WS_PRE), (bf16*)(ws + WS_PART2) + (size_t)(blockIdx.x & 3) * MS * D};
      pg8::gemm_phase<EpiResTail, MainTail, true, true>(F.lds, g, S, E, F.wave); }
    }
    GSYNC();
    for (int rep_ = 0; rep_ < REP_P9; ++rep_) {
    REFRESH();
    for (int m = 4 * F.gw; m < MP; m += 4 * F.NGW) ln_rows4<false, true>((const bf16*)(ws + WS_PRE) + (size_t)m * D, D, args.in[I_L2G], args.in[I_L2B], args.out + O_Y + (size_t)m * D, D, F.lane);
    for (int m = MP + F.gw; m < M; m += F.NGW) ln_row<false>(nullptr, args.in[I_L2G], args.in[I_L2B], args.out + O_Y + (size_t)m * D, F.lane, (const bf16*)(ws + WS_PART2) + (size_t)(m - MP) * D, H + (size_t)m * D);
    }
}

extern "C" void kernel_launch(void* const* d_in, const int* in_sizes, int n_in, void* d_out, int out_size, void* d_ws, size_t ws_size, hipStream_t stream) {
    static int grid = 0;
    if (grid == 0) {
        int dev = 0, cus = 0, per_cu = 0;
        hipGetDevice(&dev);
        hipDeviceGetAttribute(&cus, hipDeviceAttributeMultiprocessorCount, dev);
        hipFuncSetAttribute((const void*)fwd_megakernel, hipFuncAttributeMaxDynamicSharedMemorySize, LDS_BYTES);
        if (hipOccupancyMaxActiveBlocksPerMultiprocessor(&per_cu, (const void*)fwd_megakernel, NTHR, LDS_BYTES) != hipSuccess || per_cu < 1) per_cu = 1;
        (void)hipGetLastError();
        grid = cus * per_cu;
        if (n_in != 27 || ws_size < WS_END) { fprintf(stderr, "kernel_launch: unexpected n_in %d / ws %zu\n", n_in, ws_size); }
    }
    if (hipMemsetAsync(d_ws, 0, 16384, stream) != hipSuccess) { fprintf(stderr, "kernel_launch: hipMemsetAsync failed\n"); return; }
    Args a{};
    for (int i = 0; i < 27; ++i) a.in[i] = (const float*)d_in[i];
    a.out = (float*)d_out; a.ws = (unsigned char*)d_ws;
    void* kargs[] = {&a};
    hipError_t e = hipLaunchCooperativeKernel((const void*)fwd_megakernel, dim3(grid), dim3(NTHR), kargs, LDS_BYTES, stream);
    if (e != hipSuccess) fprintf(stderr, "cooperative launch failed: %s (grid %d)\n", hipGetErrorString(e), grid);
}
```
